# Optimizing an MI355X kernel written in HIP

```python
import jax, jax.numpy as jnp
from jax import lax
import numpy as np

D_MODEL = 1024
BATCH = 2
SEQ = 16384
DEPTH = 4

N_MIXERS = 3
D_HEAD = 64
ROT_DIM = D_HEAD // 4
ROPE_THETA = 500000.0
D_FF = 2816
PLE_DIM = 256
RMS_EPS = 1e-6
NEG_INF = -1e30
N_NORMS = 8
A_PAIRS = ((128, 1), (512, 4), (2048, 16))
A_HEADS = 8
A_BLOCK = 64
B_HEADS = 16
B_KV_HEADS = 4
B_RADIUS = 128
B_BLOCK = 128
C_HEADS = 16
GRID_W = 64
NA_ROWS = 8
NA_COLS = 16
NA_QC = 16
NA_KC = 2 * NA_QC

kernel_name = "hybrid_dilated_swa_natten_macaron"


def rms_norm(x, g):
    x32 = x.astype(jnp.float32)
    y = x32 * lax.rsqrt(jnp.mean(x32 * x32, axis=-1, keepdims=True) + RMS_EPS)
    return (y * g.astype(jnp.float32)).astype(x.dtype)


def swiglu(x, wi, wo):
    gate, up = jnp.split(x @ wi, 2, axis=-1)
    return (jax.nn.silu(gate) * up) @ wo


def rope_tables(seq):
    pos = jnp.arange(seq, dtype=jnp.float32)
    inv = ROPE_THETA ** (-jnp.arange(0, ROT_DIM, 2, dtype=jnp.float32) / ROT_DIM)
    ang = pos[:, None] * inv[None, :]
    return jnp.cos(ang), jnp.sin(ang)


def apply_rope(x, cos, sin):
    shape = (cos.shape[0],) + (1,) * (x.ndim - 3) + (cos.shape[1],)
    c = cos.reshape(shape).astype(x.dtype)
    s = sin.reshape(shape).astype(x.dtype)
    half = ROT_DIM // 2
    x1, x2, rest = x[..., :half], x[..., half:ROT_DIM], x[..., ROT_DIM:]
    return jnp.concatenate([x1 * c - x2 * s, x2 * c + x1 * s, rest], axis=-1)


def band_attention(q, k, v, radius, block, sink=None):
    n, length, hk, grp, dh = q.shape
    nb = -(-length // block)
    pad = nb * block - length
    qb = jnp.pad(q, ((0, 0), (0, pad), (0, 0), (0, 0), (0, 0))).reshape(n, nb, block, hk, grp, dh)

    def three_blocks(a):
        a = jnp.pad(a, ((0, 0), (block, pad + block), (0, 0), (0, 0))).reshape(n, nb + 2, block, hk, dh)
        return jnp.concatenate([a[:, :-2], a[:, 1:-1], a[:, 2:]], axis=2)

    kb, vb = three_blocks(k), three_blocks(v)
    qpos = jnp.arange(nb * block).reshape(nb, block)
    kpos = jnp.arange(nb)[:, None] * block - block + jnp.arange(3 * block)[None, :]
    rel = kpos[:, None, :] - qpos[:, :, None]
    valid = (jnp.abs(rel) <= radius) & (kpos[:, None, :] >= 0) & (kpos[:, None, :] < length)
    s = jnp.einsum('nbqhgd,nbkhd->nbhgqk', qb, kb).astype(jnp.float32) * (dh ** -0.5)
    s = jnp.where(valid[None, :, None, None], s, NEG_INF)
    m = jnp.max(s, axis=-1)
    if sink is not None:
        sk = sink.astype(jnp.float32)[None, None, :, :, None]
        m = jnp.maximum(m, sk)
    pr = jnp.exp(s - m[..., None])
    den = jnp.sum(pr, axis=-1)
    if sink is not None:
        den = den + jnp.exp(sk - m)
    o = jnp.einsum('nbhgqk,nbkhd->nbqhgd', pr.astype(v.dtype), vb)
    o = o / jnp.transpose(den, (0, 1, 4, 2, 3))[..., None]
    lse = jnp.transpose(m + jnp.log(den), (0, 1, 4, 2, 3))
    o = o.reshape(n, nb * block, hk, grp, dh)[:, :length].astype(q.dtype)
    lse = lse.reshape(n, nb * block, hk, grp)[:, :length]
    return o, lse


def dilated_mixer(h, wqkv, wo, cos, sin):
    b, s, _ = h.shape
    ng = len(A_PAIRS)
    qkv = (h @ wqkv).reshape(b, s, 3, ng, A_HEADS, D_HEAD)
    q = apply_rope(qkv[:, :, 0], cos, sin)
    k = apply_rope(qkv[:, :, 1], cos, sin)
    v = qkv[:, :, 2]
    outs, lses = [], []
    for g, (window, dil) in enumerate(A_PAIRS):
        sub = s // dil

        def to_sub(a):
            return a.reshape(b, sub, dil, A_HEADS, D_HEAD).transpose(0, 2, 1, 3, 4).reshape(b * dil, sub, A_HEADS, D_HEAD)

        o, lse = band_attention(to_sub(q[:, :, g])[:, :, :, None], to_sub(k[:, :, g]), to_sub(v[:, :, g]),
                                window // (2 * dil), A_BLOCK)
        o = o[:, :, :, 0].reshape(b, dil, sub, A_HEADS, D_HEAD).transpose(0, 2, 1, 3, 4).reshape(b, s, A_HEADS, D_HEAD)
        lse = lse[..., 0].reshape(b, dil, sub, A_HEADS).transpose(0, 2, 1, 3).reshape(b, s, A_HEADS)
        outs.append(o)
        lses.append(lse)
    wts = jax.nn.softmax(jnp.stack(lses, axis=0), axis=0)
    o = jnp.sum(wts[..., None] * jnp.stack(outs, axis=0).astype(jnp.float32), axis=0).astype(h.dtype)
    return o.reshape(b, s, A_HEADS * D_HEAD) @ wo


def window_gqa_mixer(h, wqkv, wo, sink, cos, sin):
    b, s, _ = h.shape
    grp = B_HEADS // B_KV_HEADS
    qkv = h @ wqkv
    q = qkv[..., :B_HEADS * D_HEAD].reshape(b, s, B_HEADS, D_HEAD)
    k = qkv[..., B_HEADS * D_HEAD:(B_HEADS + B_KV_HEADS) * D_HEAD].reshape(b, s, B_KV_HEADS, D_HEAD)
    v = qkv[..., (B_HEADS + B_KV_HEADS) * D_HEAD:].reshape(b, s, B_KV_HEADS, D_HEAD)
    q = apply_rope(q, cos, sin).reshape(b, s, B_KV_HEADS, grp, D_HEAD)
    k = apply_rope(k, cos, sin)
    o, _ = band_attention(q, k, v, B_RADIUS, B_BLOCK, sink.reshape(B_KV_HEADS, grp))
    return o.reshape(b, s, B_HEADS * D_HEAD) @ wo


def neighbourhood_mixer(h, wqkv, wo, rpb):
    b, s, _ = h.shape
    rows = s // GRID_W
    kh = min(NA_ROWS, rows)
    ncb = GRID_W // NA_QC
    qkv = (h @ wqkv).reshape(b, rows, GRID_W, 3, C_HEADS, D_HEAD)
    q = qkv[:, :, :, 0] * (D_HEAD ** -0.5)
    k, v = qkv[:, :, :, 1], qkv[:, :, :, 2]
    qcol = np.arange(GRID_W).reshape(ncb, NA_QC)
    kstart = np.clip(np.arange(ncb) * NA_QC - NA_COLS // 2, 0, GRID_W - NA_KC)
    kcol = kstart[:, None] + np.arange(NA_KC)[None, :]
    cstart = np.clip(qcol - NA_COLS // 2, 0, GRID_W - NA_COLS)
    col_valid = (kcol[:, None, :] >= cstart[..., None]) & (kcol[:, None, :] < cstart[..., None] + NA_COLS)
    dc_idx = np.clip(kcol[:, None, :] - qcol[:, :, None] + NA_COLS - 1, 0, 2 * NA_COLS - 2)
    kc = k[:, :, kcol]
    vc = v[:, :, kcol]

    def row_fn(r):
        rs = jnp.clip(r - kh // 2, 0, rows - kh)
        kw = lax.dynamic_slice_in_dim(kc, rs, kh, axis=1)
        vw = lax.dynamic_slice_in_dim(vc, rs, kh, axis=1)
        qr = lax.dynamic_index_in_dim(q, r, axis=1, keepdims=False).reshape(b, ncb, NA_QC, C_HEADS, D_HEAD)
        sc = jnp.einsum('bnqhd,bjnchd->bhnqjc', qr, kw).astype(jnp.float32)
        dr_idx = rs + jnp.arange(kh) - r + NA_ROWS - 1
        bias = rpb[:, dr_idx][:, :, dc_idx].transpose(0, 2, 3, 1, 4)
        sc = sc + bias.astype(jnp.float32)[None]
        sc = jnp.where(col_valid[None, None, :, :, None, :], sc, NEG_INF)
        pr = jax.nn.softmax(sc.reshape(b, C_HEADS, ncb, NA_QC, kh * NA_KC), axis=-1)
        pr = pr.reshape(b, C_HEADS, ncb, NA_QC, kh, NA_KC).astype(vw.dtype)
        o = jnp.einsum('bhnqjc,bjnchd->bnqhd', pr, vw)
        return o.reshape(b, GRID_W, C_HEADS * D_HEAD)

    out = lax.map(row_fn, jnp.arange(rows))
    return out.transpose(1, 0, 2, 3).reshape(b, s, C_HEADS * D_HEAD) @ wo


def setup_inputs(seed: int = 0) -> dict:
    key = jax.random.key(seed)
    ks = jax.random.split(key, 16)
    f32 = jnp.float32

    def dense(k, shape, fan_in):
        return jax.random.normal(k, shape, f32) * (fan_in ** -0.5)

    n_a = len(range(0, DEPTH, N_MIXERS))
    n_b = len(range(1, DEPTH, N_MIXERS))
    n_c = len(range(2, DEPTH, N_MIXERS))
    ng = len(A_PAIRS)
    return {
        "x": jax.random.normal(ks[0], (BATCH, SEQ, D_MODEL), f32),
        "p": jax.random.normal(ks[1], (DEPTH, BATCH, SEQ, PLE_DIM), f32),
        "norm_g": 1.0 + 0.02 * jax.random.normal(ks[2], (DEPTH, N_NORMS, D_MODEL), f32),
        "ffn_wi": dense(ks[3], (DEPTH, 2, D_MODEL, 2 * D_FF), D_MODEL),
        "ffn_wo": dense(ks[4], (DEPTH, 2, D_FF, D_MODEL), D_FF),
        "ple_proj": dense(ks[5], (DEPTH, PLE_DIM, D_MODEL), PLE_DIM),
        "ple_gate": dense(ks[6], (DEPTH, D_MODEL, D_MODEL), D_MODEL),
        "a_wqkv": dense(ks[7], (n_a, D_MODEL, 3 * ng * A_HEADS * D_HEAD), D_MODEL),
        "a_wo": dense(ks[8], (n_a, A_HEADS * D_HEAD, D_MODEL), A_HEADS * D_HEAD),
        "b_wqkv": dense(ks[9], (n_b, D_MODEL, (B_HEADS + 2 * B_KV_HEADS) * D_HEAD), D_MODEL),
        "b_wo": dense(ks[10], (n_b, B_HEADS * D_HEAD, D_MODEL), B_HEADS * D_HEAD),
        "b_sink": 0.5 * jax.random.normal(ks[11], (n_b, B_HEADS), f32),
        "c_wqkv": dense(ks[12], (n_c, D_MODEL, 3 * C_HEADS * D_HEAD), D_MODEL),
        "c_wo": dense(ks[13], (n_c, C_HEADS * D_HEAD, D_MODEL), C_HEADS * D_HEAD),
        "c_rpb": 0.1 * jax.random.normal(ks[14], (n_c, C_HEADS, 2 * NA_ROWS - 1, 2 * NA_COLS - 1), f32),
    }


def reference(x, p, norm_g, ffn_wi, ffn_wo, ple_proj, ple_gate, a_wqkv, a_wo,
              b_wqkv, b_wo, b_sink, c_wqkv, c_wo, c_rpb):
    cos, sin = rope_tables(x.shape[1])
    h = x
    for i in range(DEPTH):
        g = norm_g[i]
        h = h + 0.5 * rms_norm(swiglu(rms_norm(h, g[0]), ffn_wi[i, 0], ffn_wo[i, 0]), g[1])
        hn = rms_norm(h, g[2])
        mixer, j = i % N_MIXERS, i // N_MIXERS
        if mixer == 0:
            y = dilated_mixer(hn, a_wqkv[j], a_wo[j], cos, sin)
        elif mixer == 1:
            y = window_gqa_mixer(hn, b_wqkv[j], b_wo[j], b_sink[j], cos, sin)
        else:
            y = neighbourhood_mixer(hn, c_wqkv[j], c_wo[j], c_rpb[j])
        h = h + rms_norm(y, g[3])
        h = h + 0.5 * rms_norm(swiglu(rms_norm(h, g[4]), ffn_wi[i, 1], ffn_wo[i, 1]), g[5])
        e = p[i].astype(h.dtype) @ ple_proj[i]
        gate = jax.nn.sigmoid(rms_norm(h, g[6]) @ ple_gate[i])
        h = h + rms_norm(e * gate, g[7])
    return h
```

```cpp
#include <hip/hip_runtime.h>
#include <hip/hip_cooperative_groups.h>
#include <cstdio>
#include <cstdint>
namespace cg = cooperative_groups;
namespace pg8 {
#define PG8_LAS __attribute__((address_space(3)))
typedef unsigned short bf16_t;
typedef short bf16x8 __attribute__((ext_vector_type(8)));
typedef float f32x4 __attribute__((ext_vector_type(4)));
typedef unsigned u32x4 __attribute__((ext_vector_type(4)));
constexpr int BM = 256, BK = 64, HALF = 128, HTB = HALF * BK * 2  , STAGE_BYTES = 8 * HTB, NXCD = 8, WGM = 8;

__host__ __device__ __forceinline__ int lds_byte(int r, int c) { const int st = (r >> 4) * 2 + (c >> 5), rr = r & 15, cc = c & 31, ob = rr * 64 + cc * 2; return st * 1024 + (ob ^ (((ob >> 9) & 1) << 5)); }
__host__ __device__ __forceinline__ void stage_rc(int b, int& R, int& C) { const int st = b / 1024, sb = b % 1024, swz = sb ^ (((sb >> 9) & 1) << 5); R = (st >> 1) * 16 + swz / 64; C = (st & 1) * 32 + (swz % 64) / 2; }
__host__ __device__ __forceinline__ int perm32(int rho) { const int n = rho >> 4, i = rho & 15; return 8 * (i >> 2) + 4 * n + (i & 3); }

struct Unit { int pm, pn; };
struct Gemm { const bf16_t* A; const bf16_t* Bt; int M, N, K; };

struct StaticOrder {
    int nM, nN, nwg, G, c;
    __host__ __device__ void init(int M, int N, int G_, int c_) { nM = M / BM; nN = N / BM; nwg = nM * nN; G = G_; c = c_; }
    __host__ __device__ bool next(int i, Unit& u) const {
        const long L = (long)i * G + c; if (L >= nwg) return false;
        int wgid = (int)L; { const int q = nwg / NXCD, r = nwg % NXCD, xcd = wgid % NXCD, off = wgid / NXCD; wgid = (xcd < r ? xcd * (q + 1) : r * (q + 1) + (xcd - r) * q) + off; }
        const int nig = WGM * nN, gid = wgid / nig, fm = gid * WGM, gsz = (nM - fm) < WGM ? (nM - fm) : WGM;
        u.pm = fm + ((wgid % nig) % gsz); u.pn = (wgid % nig) / gsz; return true;
    }
    __device__ __forceinline__ void a_ready(const Unit&) const {}
    __device__ __forceinline__ void done(const Unit&) const {}
};

__device__ __forceinline__ unsigned cvt_pk_bf16(float lo, float hi) { unsigned r; asm volatile("v_cvt_pk_bf16_f32 %0, %1, %2" : "=v"(r) : "v"(lo), "v"(hi)); return r; }
__device__ __forceinline__ float silu_f(float g) { return g * __builtin_amdgcn_rcpf(1.0f + __expf(-g)); }

struct EpiStore {
    static constexpr bool PERM = true, AFTER_DRAIN = false;
    bf16_t* O; int ldc;
    __device__ __forceinline__ void operator()(const f32x4 (&acc)[2][2][4][2], const Unit& u, int wr, int wc, int fr, int fq) const {
        const int row0 = u.pm * BM + wr * 64 + fr; const int col0 = u.pn * BM + wc * 32 + 8 * fq;
#pragma unroll
        for (int ai = 0; ai < 2; ++ai)
#pragma unroll
            for (int m = 0; m < 4; ++m) { bf16_t* rowp = O + (size_t)(row0 + ai * HALF + m * 16) * ldc + col0;
#pragma unroll
                for (int bj = 0; bj < 2; ++bj) { const f32x4 v0 = acc[ai][bj][m][0], v1 = acc[ai][bj][m][1];
                    u32x4 w; w.x = cvt_pk_bf16(v0[0], v0[1]); w.y = cvt_pk_bf16(v0[2], v0[3]); w.z = cvt_pk_bf16(v1[0], v1[1]); w.w = cvt_pk_bf16(v1[2], v1[3]);
                    *(u32x4*)(rowp + bj * HALF) = w; } }
    }
};
struct EpiSwiGLU {
    static constexpr bool PERM = true, AFTER_DRAIN = false;
    bf16_t* O; int ldc;
    __device__ __forceinline__ void operator()(const f32x4 (&acc)[2][2][4][2], const Unit& u, int wr, int wc, int fr, int fq) const {
        const int row0 = u.pm * BM + wr * 64 + fr; const int col0 = u.pn * HALF + wc * 32 + 8 * fq;
#pragma unroll
        for (int ai = 0; ai < 2; ++ai)
#pragma unroll
            for (int m = 0; m < 4; ++m) { bf16_t* rowp = O + (size_t)(row0 + ai * HALF + m * 16) * ldc + col0;
                const f32x4 g0 = acc[ai][0][m][0], g1 = acc[ai][0][m][1], u0 = acc[ai][1][m][0], u1 = acc[ai][1][m][1];
                u32x4 w;
                w.x = cvt_pk_bf16(silu_f(g0[0]) * u0[0], silu_f(g0[1]) * u0[1]); w.y = cvt_pk_bf16(silu_f(g0[2]) * u0[2], silu_f(g0[3]) * u0[3]);
                w.z = cvt_pk_bf16(silu_f(g1[0]) * u1[0], silu_f(g1[1]) * u1[1]); w.w = cvt_pk_bf16(silu_f(g1[2]) * u1[2], silu_f(g1[3]) * u1[3]);
                *(u32x4*)rowp = w; }
    }
};
template <class Epi, class Sched, bool ALIGN_EPI = false, bool SP2 = false, int KC = 0>
__device__ __forceinline__ void gemm_phase(PG8_LAS unsigned char* lds, const Gemm g, const Sched& S, const Epi& E) {
    int tid_ = threadIdx.x; asm volatile("" : "+v"(tid_));
    const int tid = tid_, wid = __builtin_amdgcn_readfirstlane(tid >> 6), lane = tid & 63, wr = wid >> 2, wc = wid & 3, fr = lane & 15, fq = lane >> 4;
    const int K = KC ? KC : g.K, nt = K / BK;
    unsigned voffA[2], voffB[2];
#pragma unroll
    for (int i = 0; i < 2; ++i) { int R, C; stage_rc(tid * 16 + i * 8192, R, C); const int Rb = Epi::PERM ? ((R & ~31) + perm32(R & 31)) : R;
        voffA[i] = (unsigned)(R * K + C) * 2u; voffB[i] = (unsigned)(Rb * K + C) * 2u; }
    const size_t kstep = (size_t)(BK * 2);
    const size_t hstep = (size_t)HALF * K * 2;
    const size_t tstep = 2 * hstep;
    const unsigned ldsw = (unsigned)wid * 1024u;
    const int aoff = lds_byte(wr * 64 + fr, fq * 8), boff = lds_byte(wc * 32 + fr, fq * 8);
#define PG8_SA(b, h) (((b) * 2 + (h)) * HTB)
#define PG8_SB(b, h) ((4 + (b) * 2 + (h)) * HTB)
#define PG8_STAGE(bufoff, gbase, voff) do { _Pragma("unroll") for (int _i = 0; _i < 2; ++_i) \
        __builtin_amdgcn_global_load_lds((const unsigned*)((const char*)(gbase) + (voff)[_i]), (PG8_LAS unsigned*)(lds + (bufoff) + ldsw + _i * 8192), 16, 0, 0); } while (0)
#define PG8_LDA(dst, b, h) do { _Pragma("unroll") for (int m = 0; m < 4; ++m) _Pragma("unroll") for (int k = 0; k < 2; ++k) dst[m][k] = *(const PG8_LAS bf16x8*)(lds + PG8_SA(b, h) + aoff + m * 2048 + k * 1024); } while (0)
#define PG8_LDB(dst, b, h) do { _Pragma("unroll") for (int n = 0; n < 2; ++n) _Pragma("unroll") for (int k = 0; k < 2; ++k) dst[n][k] = *(const PG8_LAS bf16x8*)(lds + PG8_SB(b, h) + boff + n * 2048 + k * 1024); } while (0)
#define PG8_MMA(ai, bj, At, Bt) do { __builtin_amdgcn_s_setprio(1); _Pragma("unroll") for (int m = 0; m < 4; ++m) _Pragma("unroll") for (int n = 0; n < 2; ++n) _Pragma("unroll") for (int k = 0; k < 2; ++k) \
        acc[ai][bj][m][n] = __builtin_amdgcn_mfma_f32_16x16x32_bf16(Bt[n][k], At[m][k], acc[ai][bj][m][n], 0, 0, 0); __builtin_amdgcn_s_setprio(0); } while (0)
#define PG8_WAIT_V(n) asm volatile("s_waitcnt vmcnt(" #n ")" ::: "memory")
#define PG8_WAIT_L(n) asm volatile("s_waitcnt lgkmcnt(" #n ")" ::: "memory")
#define PG8_BAR __builtin_amdgcn_s_barrier()
#define PG8_SCHED __builtin_amdgcn_sched_barrier(0)
    Unit cur, nxt; int ui = 0;
    if (!S.next(0, cur)) return;
    f32x4 acc[2][2][4][2];
#pragma unroll
    for (int a = 0; a < 2; ++a)
#pragma unroll
        for (int b = 0; b < 2; ++b)
#pragma unroll
            for (int m = 0; m < 4; ++m)
#pragma unroll
                for (int n = 0; n < 2; ++n) acc[a][b][m][n] = (f32x4){0.f, 0.f, 0.f, 0.f};
    bf16x8 At[4][2], B0[2][2], B1[2][2];
    const char* cA = (const char*)g.A + (size_t)cur.pm * tstep; const char* cB = (const char*)g.Bt + (size_t)cur.pn * tstep;
    S.a_ready(cur);
    if constexpr (SP2) {
        PG8_STAGE(PG8_SB(0, 0), cB, voffB); PG8_STAGE(PG8_SB(0, 1), cB + hstep, voffB); PG8_STAGE(PG8_SA(0, 0), cA, voffA); PG8_STAGE(PG8_SA(0, 1), cA + hstep, voffA);
        if (wr == 1) PG8_BAR;
        PG8_WAIT_V(2); PG8_BAR;
        PG8_STAGE(PG8_SB(1, 0), cB + kstep, voffB); PG8_STAGE(PG8_SA(1, 0), cA + kstep, voffA); PG8_STAGE(PG8_SB(1, 1), cB + hstep + kstep, voffB);
        PG8_WAIT_V(6); PG8_BAR;
    } else {
        PG8_STAGE(PG8_SB(0, 0), cB, voffB); PG8_STAGE(PG8_SA(0, 0), cA, voffA); PG8_STAGE(PG8_SB(0, 1), cB + hstep, voffB); PG8_STAGE(PG8_SA(0, 1), cA + hstep, voffA);
        if (wr == 1) PG8_BAR;
        PG8_WAIT_V(4); PG8_BAR;
        PG8_STAGE(PG8_SB(1, 0), cB + kstep, voffB); PG8_STAGE(PG8_SA(1, 0), cA + kstep, voffA); PG8_STAGE(PG8_SB(1, 1), cB + hstep + kstep, voffB);
        PG8_WAIT_V(6); PG8_BAR;
    }
    for (;;) {
        const bool has_next = S.next(ui + 1, nxt);
        const char* nA = has_next ? (const char*)g.A + (size_t)nxt.pm * tstep : cA; const char* nB = has_next ? (const char*)g.Bt + (size_t)nxt.pn * tstep : cB;
        for (int t = 0; t < nt; t += 2) {
            const bool last = (t == nt - 2);
            const char* a1 = cA + (size_t)(t + 1) * kstep;
            const char* a2 = last ? nA : cA + (size_t)(t + 2) * kstep; const char* b2 = last ? nB : cB + (size_t)(t + 2) * kstep;
            const char* a3 = a2 + kstep; const char* b3 = b2 + kstep;
            if (last && has_next) S.a_ready(nxt);
            if constexpr (SP2) {
            PG8_LDB(B0, 0, 0); PG8_LDB(B1, 0, 1); PG8_SCHED; PG8_LDA(At, 0, 0); PG8_STAGE(PG8_SA(1, 1), a1 + hstep, voffA);
            PG8_WAIT_V(8); PG8_WAIT_L(0); PG8_BAR; PG8_MMA(0, 0, At, B0); PG8_MMA(0, 1, At, B1); PG8_BAR; PG8_SCHED;
            PG8_LDA(At, 0, 1); PG8_STAGE(PG8_SB(0, 0), b2, voffB); PG8_STAGE(PG8_SB(0, 1), b2 + hstep, voffB); PG8_STAGE(PG8_SA(0, 0), a2, voffA);
            PG8_WAIT_V(8); PG8_WAIT_L(0); PG8_BAR; PG8_MMA(1, 0, At, B0); PG8_MMA(1, 1, At, B1); PG8_BAR; PG8_SCHED;
            PG8_LDB(B0, 1, 0); PG8_LDB(B1, 1, 1); PG8_SCHED; PG8_LDA(At, 1, 0); PG8_STAGE(PG8_SA(0, 1), a2 + hstep, voffA);
            PG8_WAIT_V(8); PG8_WAIT_L(0); PG8_BAR; PG8_MMA(0, 0, At, B0); PG8_MMA(0, 1, At, B1); PG8_BAR; PG8_SCHED;
            PG8_LDA(At, 1, 1); PG8_STAGE(PG8_SB(1, 0), b3, voffB); PG8_STAGE(PG8_SB(1, 1), b3 + hstep, voffB); PG8_STAGE(PG8_SA(1, 0), a3, voffA);
            PG8_WAIT_V(8); PG8_WAIT_L(0); PG8_BAR; PG8_MMA(1, 0, At, B0); PG8_MMA(1, 1, At, B1); PG8_BAR; PG8_SCHED;
            } else {
            PG8_LDB(B0, 0, 0); PG8_SCHED; PG8_LDA(At, 0, 0); PG8_STAGE(PG8_SA(1, 1), a1 + hstep, voffA);
            PG8_WAIT_L(8); PG8_BAR; PG8_WAIT_L(0); PG8_MMA(0, 0, At, B0); PG8_BAR; PG8_SCHED;
            PG8_LDB(B1, 0, 1); PG8_STAGE(PG8_SB(0, 0), b2, voffB);
            PG8_BAR; PG8_WAIT_L(0); PG8_MMA(0, 1, At, B1); PG8_BAR;
            PG8_LDA(At, 0, 1); PG8_STAGE(PG8_SA(0, 0), a2, voffA);
            PG8_BAR; PG8_WAIT_L(0); PG8_MMA(1, 0, At, B0); PG8_BAR; PG8_SCHED;
            PG8_STAGE(PG8_SB(0, 1), b2 + hstep, voffB);
            PG8_WAIT_V(6); PG8_BAR; PG8_MMA(1, 1, At, B1); PG8_BAR;
            PG8_LDB(B0, 1, 0); PG8_SCHED; PG8_LDA(At, 1, 0); PG8_STAGE(PG8_SA(0, 1), a2 + hstep, voffA);
            PG8_WAIT_L(8); PG8_BAR; PG8_WAIT_L(0); PG8_MMA(0, 0, At, B0); PG8_BAR; PG8_SCHED;
            PG8_LDB(B1, 1, 1); PG8_STAGE(PG8_SB(1, 0), b3, voffB);
            PG8_BAR; PG8_WAIT_L(0); PG8_MMA(0, 1, At, B1); PG8_BAR;
            PG8_LDA(At, 1, 1); PG8_STAGE(PG8_SA(1, 0), a3, voffA);
            PG8_BAR; PG8_WAIT_L(0); PG8_MMA(1, 0, At, B0); PG8_BAR; PG8_SCHED;
            PG8_STAGE(PG8_SB(1, 1), b3 + hstep, voffB);
            PG8_WAIT_V(6); PG8_BAR; PG8_MMA(1, 1, At, B1); PG8_BAR;
            }
        }
        if constexpr (ALIGN_EPI) { if (wr == 0) PG8_BAR; }
        if constexpr (!Epi::AFTER_DRAIN) { E(acc, cur, wr, wc, fr, fq); S.done(cur); }
        if (!has_next) break;
#pragma unroll
        for (int a = 0; a < 2; ++a)
#pragma unroll
            for (int b = 0; b < 2; ++b)
#pragma unroll
                for (int m = 0; m < 4; ++m)
#pragma unroll
                    for (int n = 0; n < 2; ++n) acc[a][b][m][n] = (f32x4){0.f, 0.f, 0.f, 0.f};
        cur = nxt; cA = nA; cB = nB; ++ui;
        if constexpr (ALIGN_EPI) { if (wr == 1) PG8_BAR; }
    }
    PG8_WAIT_V(0);
    if constexpr (!ALIGN_EPI) { if (wr == 0) PG8_BAR; }
    PG8_BAR;
    if constexpr (Epi::AFTER_DRAIN) { E.fused(acc, cur, wr, wc, fr, fq, lds, wid, lane); S.done(cur); }
#undef PG8_SA
#undef PG8_SB
#undef PG8_STAGE
#undef PG8_LDA
#undef PG8_LDB
#undef PG8_MMA
#undef PG8_WAIT_V
#undef PG8_WAIT_L
#undef PG8_BAR
#undef PG8_SCHED
}
}

#define LAS __attribute__((address_space(3)))
typedef unsigned short bf16_t;
typedef float f32x4 __attribute__((ext_vector_type(4)));
typedef unsigned u32x4 __attribute__((ext_vector_type(4)));
typedef unsigned u32x2 __attribute__((ext_vector_type(2)));
constexpr int SEQ = 16384, NB = 2, M = NB * SEQ, D = 1024, DFF = 2816, DEPTH = 4, PLE = 256;
constexpr float EPS = 1e-6f;
constexpr int NWAVES = 8, NTHR = 512;
constexpr int LDS_BYTES = 147456;
constexpr int PH_PER_LAYER = 14, NPHASES = 1 + DEPTH * PH_PER_LAYER;

constexpr size_t MiB = 1u << 20;
constexpr size_t WS_CTL = 0, WS_ROPE = 1 * MiB, WS_LSE = 2 * MiB, WS_W = 8 * MiB, WS_PBF = 183 * MiB, WS_XN = 199 * MiB, WS_O = 263 * MiB, WS_BIG = 327 * MiB, WS_END = 615 * MiB;
constexpr size_t WS_Y = WS_BIG + 176 * MiB;
constexpr size_t WS_E = WS_BIG;
constexpr size_t W_WI = 0, W_WO = W_WI + (size_t)8 * D * 2 * DFF, W_PP = W_WO + (size_t)8 * DFF * D, W_PG = W_PP + (size_t)4 * PLE * D, W_AQ = W_PG + (size_t)4 * D * D,
                 W_AO = W_AQ + (size_t)2 * D * 4608, W_BQ = W_AO + (size_t)2 * 512 * D, W_BO = W_BQ + (size_t)D * 1536, W_CQ = W_BO + (size_t)D * D, W_CO = W_CQ + (size_t)D * 3072, W_END = W_CO + (size_t)D * D;
static_assert(WS_W + W_END * 2 <= WS_PBF, "weight region");

struct Args { const float* in[15]; float* out; unsigned char* ws; int ph_lo, ph_hi; };
constexpr int TAB_OFF = 131072 + 1024, T_OUT = 15, T_WS = 16;
__device__ __forceinline__ const float* tabp(LAS unsigned char* lds, int k) {
    const LAS unsigned* t = (const LAS unsigned*)(lds + TAB_OFF) + 2 * k;
    const unsigned lo = __builtin_amdgcn_readfirstlane(t[0]), hi = __builtin_amdgcn_readfirstlane(t[1]);
    return (const float*)(((unsigned long long)hi << 32) | lo);
}

__device__ __forceinline__ float bf_lo(unsigned u) { return __uint_as_float(u << 16); }
__device__ __forceinline__ float bf_hi(unsigned u) { return __uint_as_float(u & 0xffff0000u); }
__device__ __forceinline__ unsigned pk2(float lo, float hi) { return pg8::cvt_pk_bf16(lo, hi); }
__device__ __forceinline__ float wave_sum(float v) {
#pragma unroll
    for (int o = 1; o < 64; o <<= 1) v += __shfl_xor(v, o);
    return v;
}

constexpr float INV0 = 0x1.0000000000000p+0f, INV1 = 0x1.8d275e0000000p-3f, INV2 = 0x1.3411900000000p-5f, INV3 = 0x1.ddee9c0000000p-8f, INV4 = 0x1.72ba440000000p-10f, INV5 = 0x1.1f91f00000000p-12f, INV6 = 0x1.be21880000000p-15f, INV7 = 0x1.5a0f4e0000000p-17f;
__device__ __forceinline__ void transpose_item(const float* W, int K, int N, bf16_t* WT, int perm, LAS float* scr, int item, int lane) {
    const int nblk = N / 32, kb = item / nblk, nb = item % nblk, k0 = 64 * kb, n0 = 32 * nb;
    int ns = n0;
    if (perm) { const int pn = n0 >> 8, w = n0 & 255; ns = (w < 128) ? pn * 128 + w : DFF + pn * 128 + (w - 128); }
#pragma unroll 8
    for (int i = 0; i < 32; ++i) { const int kk = 2 * i + (lane >> 5); scr[kk * 33 + (lane & 31)] = W[(size_t)(k0 + kk) * N + ns + (lane & 31)]; }
    asm volatile("s_waitcnt lgkmcnt(0)" ::: "memory");
    const int c = lane & 7;
#pragma unroll
    for (int j = 0; j < 4; ++j) { const int n = (lane >> 3) + 8 * j; const LAS float* s = scr + (8 * c) * 33 + n;
        u32x4 o; o.x = pk2(s[0 * 33], s[1 * 33]); o.y = pk2(s[2 * 33], s[3 * 33]); o.z = pk2(s[4 * 33], s[5 * 33]); o.w = pk2(s[6 * 33], s[7 * 33]);
        *(u32x4*)(WT + (size_t)(n0 + n) * K + k0 + 8 * c) = o; }
    asm volatile("s_waitcnt lgkmcnt(0)" ::: "memory");
}
__device__ __forceinline__ void conv_matrix(const float* W, int K, int N, bf16_t* WT, int perm, LAS float* scr, int gw, int ngw, int lane) {
    const int nitems = (K / 64) * (N / 32);
    for (int it = gw; it < nitems; it += ngw) transpose_item(W, K, N, WT, perm, scr, it, lane);
}
__device__ __forceinline__ void first_norm_row(const float* xrow, float* hrow, bf16_t* xnrow, const float* g, int lane) {
    f32x4 v[4]; float s = 0.f;
#pragma unroll
    for (int j = 0; j < 4; ++j) { v[j] = ((const f32x4*)xrow)[lane + 64 * j]; s += (v[j].x * v[j].x + v[j].y * v[j].y) + (v[j].z * v[j].z + v[j].w * v[j].w); }
    const float rstd = 1.0f / sqrtf(wave_sum(s) * (1.0f / D) + EPS);
#pragma unroll
    for (int j = 0; j < 4; ++j) { ((f32x4*)hrow)[lane + 64 * j] = v[j]; const f32x4 gg = ((const f32x4*)g)[lane + 64 * j];
        u32x2 w; w.x = pk2(v[j].x * rstd * gg.x, v[j].y * rstd * gg.y); w.y = pk2(v[j].z * rstd * gg.z, v[j].w * rstd * gg.w);
        ((u32x2*)xnrow)[lane + 64 * j] = w; }
}
__device__ __forceinline__ void prologue(LAS unsigned char* lds, int G, int bx) {
    unsigned char* const ws = (unsigned char*)tabp(lds, T_WS);
    int tid_ = threadIdx.x; asm volatile("" : "+v"(tid_));
    const int tid = tid_, lane = tid & 63, wave = tid >> 6;
    const int gw = bx * NWAVES + wave, ngw = G * NWAVES;
    LAS float* scr = (LAS float*)(lds + wave * 16384);
    bf16_t* Wb = (bf16_t*)(ws + WS_W);
    for (int i = 0; i < 8; ++i) conv_matrix(tabp(lds, 3) + (size_t)i * D * 2 * DFF, D, 2 * DFF, Wb + W_WI + (size_t)i * D * 2 * DFF, 1, scr, gw, ngw, lane);
    for (int i = 0; i < 8; ++i) conv_matrix(tabp(lds, 4) + (size_t)i * DFF * D, DFF, D, Wb + W_WO + (size_t)i * DFF * D, 0, scr, gw, ngw, lane);
    for (int i = 0; i < 4; ++i) conv_matrix(tabp(lds, 5) + (size_t)i * PLE * D, PLE, D, Wb + W_PP + (size_t)i * PLE * D, 0, scr, gw, ngw, lane);
    for (int i = 0; i < 4; ++i) conv_matrix(tabp(lds, 6) + (size_t)i * D * D, D, D, Wb + W_PG + (size_t)i * D * D, 0, scr, gw, ngw, lane);
    for (int i = 0; i < 2; ++i) conv_matrix(tabp(lds, 7) + (size_t)i * D * 4608, D, 4608, Wb + W_AQ + (size_t)i * D * 4608, 0, scr, gw, ngw, lane);
    for (int i = 0; i < 2; ++i) conv_matrix(tabp(lds, 8) + (size_t)i * 512 * D, 512, D, Wb + W_AO + (size_t)i * 512 * D, 0, scr, gw, ngw, lane);
    conv_matrix(tabp(lds, 9), D, 1536, Wb + W_BQ, 0, scr, gw, ngw, lane);
    conv_matrix(tabp(lds, 10), D, D, Wb + W_BO, 0, scr, gw, ngw, lane);
    conv_matrix(tabp(lds, 12), D, 3072, Wb + W_CQ, 0, scr, gw, ngw, lane);
    conv_matrix(tabp(lds, 13), D, D, Wb + W_CO, 0, scr, gw, ngw, lane);
    float* rc = (float*)(ws + WS_ROPE); float* rs = rc + SEQ * 8;
    for (int i = bx * NTHR + tid; i < SEQ * 8; i += G * NTHR) { const int pos = i >> 3, f = i & 7;
        const float inv = f == 0 ? INV0 : f == 1 ? INV1 : f == 2 ? INV2 : f == 3 ? INV3 : f == 4 ? INV4 : f == 5 ? INV5 : f == 6 ? INV6 : INV7;
        const float ang = (float)pos * inv; double t = (double)ang * 0.15915494309189535; t -= rint(t);
        rc[i] = __builtin_amdgcn_cosf((float)t); rs[i] = __builtin_amdgcn_sinf((float)t); }
    bf16_t* XN = (bf16_t*)(ws + WS_XN);
    const float* xin = tabp(lds, 0); float* hout = (float*)tabp(lds, T_OUT); const float* g00 = tabp(lds, 2);
    for (int m = gw; m < M; m += ngw) first_norm_row(xin + (size_t)m * D, hout + (size_t)m * D, XN + (size_t)m * D, g00, lane);
}

__device__ __forceinline__ void norm_rows(const bf16_t* Y, const bf16_t* E, float c, const float* g1, const float* g2, float* H, bf16_t* XN, int gw, int ngw, int lane) {
    for (int m = gw; m < M; m += ngw) {
        f32x4 y[4]; float s = 0.f;
#pragma unroll
        for (int j = 0; j < 4; ++j) { const u32x2 w = ((const u32x2*)(Y + (size_t)m * D))[lane + 64 * j]; y[j] = (f32x4){bf_lo(w.x), bf_hi(w.x), bf_lo(w.y), bf_hi(w.y)};
            if (E) { const u32x2 e = ((const u32x2*)(E + (size_t)m * D))[lane + 64 * j]; const f32x4 ev = (f32x4){bf_lo(e.x), bf_hi(e.x), bf_lo(e.y), bf_hi(e.y)};
#pragma unroll
                for (int k = 0; k < 4; ++k) y[j][k] = ev[k] / (1.0f + __expf(-y[j][k])); }
            s += (y[j].x * y[j].x + y[j].y * y[j].y) + (y[j].z * y[j].z + y[j].w * y[j].w); }
        const float rstd = 1.0f / sqrtf(wave_sum(s) * (1.0f / D) + EPS);
        f32x4 h[4]; float s2 = 0.f;
#pragma unroll
        for (int j = 0; j < 4; ++j) { const f32x4 hv = ((const f32x4*)(H + (size_t)m * D))[lane + 64 * j]; const f32x4 gg = ((const f32x4*)g1)[lane + 64 * j];
            h[j] = hv + c * (y[j] * rstd) * gg; s2 += (h[j].x * h[j].x + h[j].y * h[j].y) + (h[j].z * h[j].z + h[j].w * h[j].w); }
        const float rstd2 = 1.0f / sqrtf(wave_sum(s2) * (1.0f / D) + EPS);
#pragma unroll
        for (int j = 0; j < 4; ++j) { ((f32x4*)(H + (size_t)m * D))[lane + 64 * j] = h[j]; const f32x4 gg = ((const f32x4*)g2)[lane + 64 * j];
            u32x2 w; w.x = pk2(h[j].x * rstd2 * gg.x, h[j].y * rstd2 * gg.y); w.y = pk2(h[j].z * rstd2 * gg.z, h[j].w * rstd2 * gg.w);
            ((u32x2*)(XN + (size_t)m * D))[lane + 64 * j] = w; }
    }
}
__device__ __forceinline__ void conv_p(const float* P, bf16_t* PB, int gt, int ngt) {
    for (int i = gt; i < M * PLE / 8; i += ngt) { const f32x4 a = ((const f32x4*)P)[2 * i], b = ((const f32x4*)P)[2 * i + 1];
        u32x4 w; w.x = pk2(a.x, a.y); w.y = pk2(a.z, a.w); w.z = pk2(b.x, b.y); w.w = pk2(b.z, b.w); ((u32x4*)PB)[i] = w; }
}

__device__ __forceinline__ void rope_pass(bf16_t* QKV, int ld, int nrh, const float* rc, const float* rs, int gt, int ngt) {
    for (int it = gt; it < M * nrh; it += ngt) { const int row = it / nrh, hh = it % nrh, pos = row % SEQ;
        u32x4* p = (u32x4*)(QKV + (size_t)row * ld + hh * 64); const u32x4 w1 = p[0], w2 = p[1];
        const f32x4 c0 = ((const f32x4*)(rc + pos * 8))[0], c1 = ((const f32x4*)(rc + pos * 8))[1], s0 = ((const f32x4*)(rs + pos * 8))[0], s1 = ((const f32x4*)(rs + pos * 8))[1];
        float x1[8], x2[8], cc[8], ss[8], o1[8], o2[8];
#pragma unroll
        for (int k = 0; k < 4; ++k) { x1[2 * k] = bf_lo(w1[k]); x1[2 * k + 1] = bf_hi(w1[k]); x2[2 * k] = bf_lo(w2[k]); x2[2 * k + 1] = bf_hi(w2[k]); cc[k] = c0[k]; cc[4 + k] = c1[k]; ss[k] = s0[k]; ss[4 + k] = s1[k]; }
#pragma unroll
        for (int k = 0; k < 8; ++k) { o1[k] = x1[k] * cc[k] - x2[k] * ss[k]; o2[k] = x2[k] * cc[k] + x1[k] * ss[k]; }
        u32x4 r1, r2;
#pragma unroll
        for (int k = 0; k < 4; ++k) { r1[k] = pk2(o1[2 * k], o1[2 * k + 1]); r2[k] = pk2(o2[2 * k], o2[2 * k + 1]); }
        p[0] = r1; p[1] = r2; }
}

template <class KF>
__device__ __forceinline__ void naive_core(const bf16_t* qp, float m0, float l0, int nk, KF kf, float (&o)[64], float& m, float& l) {
    u32x4 q[8];
#pragma unroll
    for (int c = 0; c < 8; ++c) q[c] = ((const u32x4*)qp)[c];
    m = m0; l = l0;
#pragma unroll
    for (int d = 0; d < 64; ++d) o[d] = 0.f;
    for (int j = 0; j < nk; ++j) {
        const bf16_t* kp; const bf16_t* vp; float bias;
        if (!kf(j, kp, vp, bias)) continue;
        float s = 0.f;
#pragma unroll
        for (int c = 0; c < 8; ++c) { const u32x4 w = ((const u32x4*)kp)[c];
#pragma unroll
            for (int k = 0; k < 4; ++k) { s += bf_lo(q[c][k]) * bf_lo(w[k]); s += bf_hi(q[c][k]) * bf_hi(w[k]); } }
        s = s * 0.125f + bias;
        const float mn = fmaxf(m, s), al = __expf(m - mn), p = __expf(s - mn);
        l = l * al + p; m = mn;
#pragma unroll
        for (int c = 0; c < 8; ++c) { const u32x4 w = ((const u32x4*)vp)[c];
#pragma unroll
            for (int k = 0; k < 4; ++k) { o[8 * c + 2 * k] = o[8 * c + 2 * k] * al + p * bf_lo(w[k]); o[8 * c + 2 * k + 1] = o[8 * c + 2 * k + 1] * al + p * bf_hi(w[k]); } }
    }
}
__device__ __forceinline__ void store_o64(bf16_t* op, const float (&o)[64], float inv) {
#pragma unroll
    for (int c = 0; c < 8; ++c) { u32x4 w;
#pragma unroll
        for (int k = 0; k < 4; ++k) w[k] = pk2(o[8 * c + 2 * k] * inv, o[8 * c + 2 * k + 1] * inv);
        ((u32x4*)op)[c] = w; }
}
__device__ __forceinline__ void attn_naive_A(const bf16_t* QKV, bf16_t* OG0, bf16_t* OG1, bf16_t* OG2, float* LSE, int gt, int ngt) {
    for (int it = gt; it < M * 24; it += ngt) { const int gh = it / M, row = it % M, g = gh >> 3, h = gh & 7, pos = row % SEQ, dil = (g == 0) ? 1 : (g == 1 ? 4 : 16);
        const bf16_t* base = QKV + (size_t)row * 4608 + gh * 64;
        float o[64], m, l;
        naive_core(base, -1e30f, 0.f, 129, [&](int j, const bf16_t*& kp, const bf16_t*& vp, float& bias) -> bool {
            const int kpos = pos + (j - 64) * dil; if (kpos < 0 || kpos >= SEQ) return false;
            const bf16_t* kb = base + (ptrdiff_t)((j - 64) * dil) * 4608; kp = kb + 1536; vp = kb + 3072; bias = 0.f; return true; }, o, m, l);
        bf16_t* OG = (g == 0) ? OG0 : (g == 1 ? OG1 : OG2);
        store_o64(OG + (size_t)row * 512 + h * 64, o, 1.0f / l);
        LSE[((size_t)g * M + row) * 8 + h] = m + __logf(l); }
}
__device__ __forceinline__ void merge_A(const bf16_t* OG0, const bf16_t* OG1, const bf16_t* OG2, const float* LSE, bf16_t* O, int gt, int ngt) {
    for (int it = gt; it < M * 64; it += ngt) { const int row = it >> 6, h = (it >> 3) & 7, c = it & 7;
        const float l0 = LSE[((size_t)0 * M + row) * 8 + h], l1 = LSE[((size_t)1 * M + row) * 8 + h], l2 = LSE[((size_t)2 * M + row) * 8 + h];
        const float mx = fmaxf(l0, fmaxf(l1, l2)); float e0 = __expf(l0 - mx), e1 = __expf(l1 - mx), e2 = __expf(l2 - mx); const float inv = 1.0f / (e0 + e1 + e2); e0 *= inv; e1 *= inv; e2 *= inv;
        const size_t off = (size_t)row * 512 + h * 64 + c * 8;
        const u32x4 a = *(const u32x4*)(OG0 + off), b = *(const u32x4*)(OG1 + off), d = *(const u32x4*)(OG2 + off); u32x4 w;
#pragma unroll
        for (int k = 0; k < 4; ++k) w[k] = pk2(e0 * bf_lo(a[k]) + e1 * bf_lo(b[k]) + e2 * bf_lo(d[k]), e0 * bf_hi(a[k]) + e1 * bf_hi(b[k]) + e2 * bf_hi(d[k]));
        *(u32x4*)(O + off) = w; }
}
__device__ __forceinline__ void attn_naive_B(const bf16_t* QKV, const float* sink, bf16_t* O, int gt, int ngt) {
    for (int it = gt; it < M * 16; it += ngt) { const int h = it / M, row = it % M, pos = row % SEQ, kvh = h >> 2;
        const bf16_t* qp = QKV + (size_t)row * 1536 + h * 64;
        const bf16_t* kb0 = QKV + (size_t)row * 1536 + 1024 + kvh * 64;
        float o[64], m, l;
        naive_core(qp, sink[h], 1.0f, 257, [&](int j, const bf16_t*& kp, const bf16_t*& vp, float& bias) -> bool {
            const int kpos = pos + j - 128; if (kpos < 0 || kpos >= SEQ) return false;
            kp = kb0 + (ptrdiff_t)(j - 128) * 1536; vp = kp + 256; bias = 0.f; return true; }, o, m, l);
        store_o64(O + (size_t)row * 1024 + h * 64, o, 1.0f / l); }
}
__device__ __forceinline__ void attn_naive_C(const bf16_t* QKV, const float* rpb, bf16_t* O, int gt, int ngt) {
    for (int it = gt; it < M * 16; it += ngt) { const int h = it / M, row = it % M, b = row / SEQ, pos = row % SEQ, r = pos >> 6, c = pos & 63;
        const int rs = min(max(r - 4, 0), 248), cs = min(max(c - 8, 0), 48);
        const bf16_t* qp = QKV + (size_t)row * 3072 + h * 64;
        float o[64], m, l;
        naive_core(qp, -1e30f, 0.f, 128, [&](int j, const bf16_t*& kp, const bf16_t*& vp, float& bias) -> bool {
            const int kr = rs + (j >> 4), kc = cs + (j & 15); const size_t krow = (size_t)b * SEQ + kr * 64 + kc;
            kp = QKV + krow * 3072 + 1024 + h * 64; vp = kp + 1024; bias = rpb[h * 465 + (kr - r + 7) * 31 + (kc - c + 15)]; return true; }, o, m, l);
        store_o64(O + (size_t)row * 1024 + h * 64, o, 1.0f / l); }
}

__device__ __forceinline__ void run_phase(LAS unsigned char* lds, int ph) {
    int tid_ = threadIdx.x; asm volatile("" : "+v"(tid_));
    int G_ = gridDim.x, bx_ = blockIdx.x; asm volatile("" : "+s"(G_), "+s"(bx_));
    const int tid = tid_, lane = tid & 63, wave = tid >> 6, G = G_, bx = bx_;
    const int gw = bx * NWAVES + wave, ngw = G * NWAVES, gt = bx * NTHR + tid, ngt = G * NTHR;
    if (ph == 0) { prologue(lds, G, bx); return; }
    const int L = (ph - 1) / PH_PER_LAYER, s = (ph - 1) % PH_PER_LAYER, mt = L % 3, mj = L / 3;
    unsigned char* ws = (unsigned char*)tabp(lds, T_WS);
    bf16_t* Wb = (bf16_t*)(ws + WS_W); bf16_t* XN = (bf16_t*)(ws + WS_XN); bf16_t* Ob = (bf16_t*)(ws + WS_O); bf16_t* BIG = (bf16_t*)(ws + WS_BIG);
    bf16_t* Yb = (bf16_t*)(ws + WS_Y); bf16_t* Eb = (bf16_t*)(ws + WS_E); bf16_t* PB = (bf16_t*)(ws + WS_PBF);
    float* LSE = (float*)(ws + WS_LSE); const float* rc = (const float*)(ws + WS_ROPE); const float* rs = rc + SEQ * 8;
    const float* gL = tabp(lds, 2) + (size_t)L * 8 * D; float* Hout = (float*)tabp(lds, T_OUT);
    const int nqkv = (mt == 0) ? 4608 : (mt == 1 ? 1536 : 3072);
    bf16_t* OG0 = XN; bf16_t* OG1 = XN + (size_t)M * 512; bf16_t* OG2 = Ob + (size_t)M * 512;
#define GEMM_STORE(KC_, A_, W_, N_, O_, LDC_) do { pg8::Gemm g{A_, W_, M, N_, KC_}; pg8::StaticOrder S; S.init(M, N_, G, bx); pg8::EpiStore E{O_, LDC_}; \
        pg8::gemm_phase<pg8::EpiStore, pg8::StaticOrder, false, true, KC_>(lds, g, S, E); } while (0)
    if (s == 0 || s == 9) {
        pg8::Gemm g{XN, Wb + W_WI + (size_t)(L * 2 + (s == 9)) * D * 2 * DFF, M, 2 * DFF, D}; pg8::StaticOrder S; S.init(M, 2 * DFF, G, bx);
        pg8::EpiSwiGLU E{BIG, DFF};
        pg8::gemm_phase<pg8::EpiSwiGLU, pg8::StaticOrder, false, true, D>(lds, g, S, E);
        return;
    }
    if (s == 1 || s == 10) { GEMM_STORE(DFF, BIG, Wb + W_WO + (size_t)(L * 2 + (s == 10)) * DFF * D, D, Yb, D); return; }
    if (s == 3 || s == 7 || s == 12) {
        if (s == 7 && mt == 0) { GEMM_STORE(512, Ob, Wb + W_AO + (size_t)mj * 512 * D, D, Yb, D); return; }
        if (s == 12) { GEMM_STORE(PLE, PB, Wb + W_PP + (size_t)L * PLE * D, D, Eb, D); __syncthreads(); }
        const bf16_t* A_; const bf16_t* W_; bf16_t* O_; int N_;
        if (s == 3) { A_ = XN; W_ = (mt == 0) ? Wb + W_AQ + (size_t)mj * D * 4608 : (mt == 1 ? Wb + W_BQ : Wb + W_CQ); N_ = nqkv; O_ = BIG; }
        else if (s == 7) { A_ = Ob; W_ = (mt == 1) ? Wb + W_BO : Wb + W_CO; N_ = D; O_ = Yb; }
        else { A_ = XN; W_ = Wb + W_PG + (size_t)L * D * D; N_ = D; O_ = Yb; }
        GEMM_STORE(D, A_, W_, N_, O_, N_);
        return;
    }
    if (s == 2) { norm_rows(Yb, nullptr, 0.5f, gL + 1 * D, gL + 2 * D, Hout, XN, gw, ngw, lane); return; }
    if (s == 8) { norm_rows(Yb, nullptr, 1.0f, gL + 3 * D, gL + 4 * D, Hout, XN, gw, ngw, lane); conv_p(tabp(lds, 1) + (size_t)L * M * PLE, PB, gt, ngt); return; }
    if (s == 11) { norm_rows(Yb, nullptr, 0.5f, gL + 5 * D, gL + 6 * D, Hout, XN, gw, ngw, lane); return; }
    if (s == 13) { const float* gn = tabp(lds, 2) + (size_t)((L + 1) % DEPTH) * 8 * D; norm_rows(Yb, Eb, 1.0f, gL + 7 * D, gn, Hout, XN, gw, ngw, lane); return; }
    if (s == 4) { if (mt == 0) rope_pass(BIG, 4608, 48, rc, rs, gt, ngt); else if (mt == 1) rope_pass(BIG, 1536, 20, rc, rs, gt, ngt); return; }
    if (s == 5) {
        if (mt == 0) attn_naive_A(BIG, OG0, OG1, OG2, LSE, gt, ngt);
        else if (mt == 1) attn_naive_B(BIG, tabp(lds, 11), Ob, gt, ngt);
        else attn_naive_C(BIG, tabp(lds, 14), Ob, gt, ngt);
        return;
    }
    if (s == 6) { if (mt == 0) merge_A(OG0, OG1, OG2, LSE, Ob, gt, ngt); return; }
}

__global__ void __launch_bounds__(NTHR) mk_fwd(Args a) {
    extern __shared__ __attribute__((aligned(16))) unsigned char lds_raw[];
    LAS unsigned char* lds = (LAS unsigned char*)lds_raw;
    cg::grid_group grid = cg::this_grid();
    if (threadIdx.x == 0) { LAS unsigned long long* t = (LAS unsigned long long*)(lds + TAB_OFF);
#pragma unroll
        for (int k = 0; k < 15; ++k) t[k] = (unsigned long long)a.in[k];
        t[T_OUT] = (unsigned long long)a.out; t[T_WS] = (unsigned long long)a.ws; }
    __syncthreads();
    const int lo = a.ph_lo, hi = a.ph_hi;
    for (int ph = lo; ph < hi; ++ph) {
        run_phase(lds, ph);
        if (ph + 1 < hi) grid.sync();
    }
}

#ifndef MK_ONE_LAUNCH
#define MK_ONE_LAUNCH 1
#endif
extern "C" void kernel_launch(void* const* d_in, const int* in_sizes, int n_in, void* d_out, int out_size, void* d_ws, size_t ws_size, hipStream_t stream) {
    static int grid = 0;
    if (grid == 0) {
        if (n_in != 15 || out_size != M * D || ws_size < WS_END) { fprintf(stderr, "kernel_launch: unexpected shapes: n_in %d out %d ws %zu (need %zu)\n", n_in, out_size, ws_size, (size_t)WS_END); grid = -1; return; }
        int dev = 0, cus = 0, per_cu = 0;
        hipGetDevice(&dev); hipDeviceGetAttribute(&cus, hipDeviceAttributeMultiprocessorCount, dev);
        if (hipFuncSetAttribute((const void*)mk_fwd, hipFuncAttributeMaxDynamicSharedMemorySize, LDS_BYTES) != hipSuccess) { fprintf(stderr, "kernel_launch: hipFuncSetAttribute failed\n"); grid = -1; return; }
        hipOccupancyMaxActiveBlocksPerMultiprocessor(&per_cu, (const void*)mk_fwd, NTHR, LDS_BYTES);
        (void)hipGetLastError();
        if (per_cu < 1) { fprintf(stderr, "kernel_launch: occupancy query says %d blocks/CU\n", per_cu); per_cu = 1; }
        grid = cus;
    }
    if (grid < 0) return;
    Args a{};
    for (int i = 0; i < 15; ++i) a.in[i] = (const float*)d_in[i];
    a.out = (float*)d_out; a.ws = (unsigned char*)d_ws;
#if MK_ONE_LAUNCH
    a.ph_lo = 0; a.ph_hi = NPHASES;
    void* args[] = {&a};
    hipError_t e = hipLaunchCooperativeKernel((const void*)mk_fwd, dim3(grid), dim3(NTHR), args, LDS_BYTES, stream);
    if (e != hipSuccess) fprintf(stderr, "cooperative launch failed: %s (grid %d)\n", hipGetErrorString(e), grid);
#else
    for (int ph = 0; ph < NPHASES; ++ph) {
        a.ph_lo = ph; a.ph_hi = ph + 1;
        hipLaunchKernelGGL(mk_fwd, dim3(grid), dim3(NTHR), LDS_BYTES, stream, a);
    }
#endif
}
```

```cpp
#include <hip/hip_runtime.h>
#include <hip/hip_cooperative_groups.h>
#include <cstdio>
#include <cstdint>
namespace cg = cooperative_groups;
namespace pg8 {
#define PG8_LAS __attribute__((address_space(3)))
typedef unsigned short bf16_t;
typedef short bf16x8 __attribute__((ext_vector_type(8)));
typedef float f32x4 __attribute__((ext_vector_type(4)));
typedef unsigned u32x4 __attribute__((ext_vector_type(4)));
constexpr int BM = 256, BK = 64, HALF = 128, HTB = HALF * BK * 2  , STAGE_BYTES = 8 * HTB, NXCD = 8, WGM = 8;

__host__ __device__ __forceinline__ int lds_byte(int r, int c) { const int st = (r >> 4) * 2 + (c >> 5), rr = r & 15, cc = c & 31, ob = rr * 64 + cc * 2; return st * 1024 + (ob ^ (((ob >> 9) & 1) << 5)); }
__host__ __device__ __forceinline__ void stage_rc(int b, int& R, int& C) { const int st = b / 1024, sb = b % 1024, swz = sb ^ (((sb >> 9) & 1) << 5); R = (st >> 1) * 16 + swz / 64; C = (st & 1) * 32 + (swz % 64) / 2; }
__host__ __device__ __forceinline__ int perm32(int rho) { const int n = rho >> 4, i = rho & 15; return 8 * (i >> 2) + 4 * n + (i & 3); }

struct Unit { int pm, pn; };
struct Gemm { const bf16_t* A; const bf16_t* Bt; int M, N, K; };

struct StaticOrder {
    int nM, nN, nwg, G, c;
    __host__ __device__ void init(int M, int N, int G_, int c_) { nM = M / BM; nN = N / BM; nwg = nM * nN; G = G_; c = c_; }
    __host__ __device__ bool next(int i, Unit& u) const {
        const long L = (long)i * G + c; if (L >= nwg) return false;
        int wgid = (int)L; { const int q = nwg / NXCD, r = nwg % NXCD, xcd = wgid % NXCD, off = wgid / NXCD; wgid = (xcd < r ? xcd * (q + 1) : r * (q + 1) + (xcd - r) * q) + off; }
        const int nig = WGM * nN, gid = wgid / nig, fm = gid * WGM, gsz = (nM - fm) < WGM ? (nM - fm) : WGM;
        u.pm = fm + ((wgid % nig) % gsz); u.pn = (wgid % nig) / gsz; return true;
    }
    __device__ __forceinline__ void a_ready(const Unit&) const {}
    __device__ __forceinline__ void done(const Unit&) const {}
};

__device__ __forceinline__ unsigned cvt_pk_bf16(float lo, float hi) { unsigned r; asm volatile("v_cvt_pk_bf16_f32 %0, %1, %2" : "=v"(r) : "v"(lo), "v"(hi)); return r; }
__device__ __forceinline__ float silu_f(float g) { return g * __builtin_amdgcn_rcpf(1.0f + __expf(-g)); }

struct EpiStore {
    static constexpr bool PERM = true, AFTER_DRAIN = false;
    bf16_t* O; int ldc;
    __device__ __forceinline__ void operator()(const f32x4 (&acc)[2][2][4][2], const Unit& u, int wr, int wc, int fr, int fq) const {
        const int row0 = u.pm * BM + wr * 64 + fr; const int col0 = u.pn * BM + wc * 32 + 8 * fq;
#pragma unroll
        for (int ai = 0; ai < 2; ++ai)
#pragma unroll
            for (int m = 0; m < 4; ++m) { bf16_t* rowp = O + (size_t)(row0 + ai * HALF + m * 16) * ldc + col0;
#pragma unroll
                for (int bj = 0; bj < 2; ++bj) { const f32x4 v0 = acc[ai][bj][m][0], v1 = acc[ai][bj][m][1];
                    u32x4 w; w.x = cvt_pk_bf16(v0[0], v0[1]); w.y = cvt_pk_bf16(v0[2], v0[3]); w.z = cvt_pk_bf16(v1[0], v1[1]); w.w = cvt_pk_bf16(v1[2], v1[3]);
                    *(u32x4*)(rowp + bj * HALF) = w; } }
    }
};
struct EpiSwiGLU {
    static constexpr bool PERM = true, AFTER_DRAIN = false;
    bf16_t* O; int ldc;
    __device__ __forceinline__ void operator()(const f32x4 (&acc)[2][2][4][2], const Unit& u, int wr, int wc, int fr, int fq) const {
        const int row0 = u.pm * BM + wr * 64 + fr; const int col0 = u.pn * HALF + wc * 32 + 8 * fq;
#pragma unroll
        for (int ai = 0; ai < 2; ++ai)
#pragma unroll
            for (int m = 0; m < 4; ++m) { bf16_t* rowp = O + (size_t)(row0 + ai * HALF + m * 16) * ldc + col0;
                const f32x4 g0 = acc[ai][0][m][0], g1 = acc[ai][0][m][1], u0 = acc[ai][1][m][0], u1 = acc[ai][1][m][1];
                u32x4 w;
                w.x = cvt_pk_bf16(silu_f(g0[0]) * u0[0], silu_f(g0[1]) * u0[1]); w.y = cvt_pk_bf16(silu_f(g0[2]) * u0[2], silu_f(g0[3]) * u0[3]);
                w.z = cvt_pk_bf16(silu_f(g1[0]) * u1[0], silu_f(g1[1]) * u1[1]); w.w = cvt_pk_bf16(silu_f(g1[2]) * u1[2], silu_f(g1[3]) * u1[3]);
                *(u32x4*)rowp = w; }
    }
};
template <class Epi, class Sched, bool ALIGN_EPI = false, bool SP2 = false, int KC = 0>
__device__ __forceinline__ void gemm_phase(PG8_LAS unsigned char* lds, const Gemm g, const Sched& S, const Epi& E) {
    int tid_ = threadIdx.x; asm volatile("" : "+v"(tid_));
    const int tid = tid_, wid = __builtin_amdgcn_readfirstlane(tid >> 6), lane = tid & 63, wr = wid >> 2, wc = wid & 3, fr = lane & 15, fq = lane >> 4;
    const int K = KC ? KC : g.K, nt = K / BK;
    unsigned voffA[2], voffB[2];
#pragma unroll
    for (int i = 0; i < 2; ++i) { int R, C; stage_rc(tid * 16 + i * 8192, R, C); const int Rb = Epi::PERM ? ((R & ~31) + perm32(R & 31)) : R;
        voffA[i] = (unsigned)(R * K + C) * 2u; voffB[i] = (unsigned)(Rb * K + C) * 2u; }
    const size_t kstep = (size_t)(BK * 2);
    const size_t hstep = (size_t)HALF * K * 2;
    const size_t tstep = 2 * hstep;
    const unsigned ldsw = (unsigned)wid * 1024u;
    const int aoff = lds_byte(wr * 64 + fr, fq * 8), boff = lds_byte(wc * 32 + fr, fq * 8);
#define PG8_SA(b, h) (((b) * 2 + (h)) * HTB)
#define PG8_SB(b, h) ((4 + (b) * 2 + (h)) * HTB)
#define PG8_STAGE(bufoff, gbase, voff) do { _Pragma("unroll") for (int _i = 0; _i < 2; ++_i) \
        __builtin_amdgcn_global_load_lds((const unsigned*)((const char*)(gbase) + (voff)[_i]), (PG8_LAS unsigned*)(lds + (bufoff) + ldsw + _i * 8192), 16, 0, 0); } while (0)
#define PG8_LDA(dst, b, h) do { _Pragma("unroll") for (int m = 0; m < 4; ++m) _Pragma("unroll") for (int k = 0; k < 2; ++k) dst[m][k] = *(const PG8_LAS bf16x8*)(lds + PG8_SA(b, h) + aoff + m * 2048 + k * 1024); } while (0)
#define PG8_LDB(dst, b, h) do { _Pragma("unroll") for (int n = 0; n < 2; ++n) _Pragma("unroll") for (int k = 0; k < 2; ++k) dst[n][k] = *(const PG8_LAS bf16x8*)(lds + PG8_SB(b, h) + boff + n * 2048 + k * 1024); } while (0)
#define PG8_MMA(ai, bj, At, Bt) do { __builtin_amdgcn_s_setprio(1); _Pragma("unroll") for (int m = 0; m < 4; ++m) _Pragma("unroll") for (int n = 0; n < 2; ++n) _Pragma("unroll") for (int k = 0; k < 2; ++k) \
        acc[ai][bj][m][n] = __builtin_amdgcn_mfma_f32_16x16x32_bf16(Bt[n][k], At[m][k], acc[ai][bj][m][n], 0, 0, 0); __builtin_amdgcn_s_setprio(0); } while (0)
#define PG8_WAIT_V(n) asm volatile("s_waitcnt vmcnt(" #n ")" ::: "memory")
#define PG8_WAIT_L(n) asm volatile("s_waitcnt lgkmcnt(" #n ")" ::: "memory")
#define PG8_BAR __builtin_amdgcn_s_barrier()
#define PG8_SCHED __builtin_amdgcn_sched_barrier(0)
    Unit cur, nxt; int ui = 0;
    if (!S.next(0, cur)) return;
    f32x4 acc[2][2][4][2];
#pragma unroll
    for (int a = 0; a < 2; ++a)
#pragma unroll
        for (int b = 0; b < 2; ++b)
#pragma unroll
            for (int m = 0; m < 4; ++m)
#pragma unroll
                for (int n = 0; n < 2; ++n) acc[a][b][m][n] = (f32x4){0.f, 0.f, 0.f, 0.f};
    bf16x8 At[4][2], B0[2][2], B1[2][2];
    const char* cA = (const char*)g.A + (size_t)cur.pm * tstep; const char* cB = (const char*)g.Bt + (size_t)cur.pn * tstep;
    S.a_ready(cur);
    if constexpr (SP2) {
        PG8_STAGE(PG8_SB(0, 0), cB, voffB); PG8_STAGE(PG8_SB(0, 1), cB + hstep, voffB); PG8_STAGE(PG8_SA(0, 0), cA, voffA); PG8_STAGE(PG8_SA(0, 1), cA + hstep, voffA);
        if (wr == 1) PG8_BAR;
        PG8_WAIT_V(2); PG8_BAR;
        PG8_STAGE(PG8_SB(1, 0), cB + kstep, voffB); PG8_STAGE(PG8_SA(1, 0), cA + kstep, voffA); PG8_STAGE(PG8_SB(1, 1), cB + hstep + kstep, voffB);
        PG8_WAIT_V(6); PG8_BAR;
    } else {
        PG8_STAGE(PG8_SB(0, 0), cB, voffB); PG8_STAGE(PG8_SA(0, 0), cA, voffA); PG8_STAGE(PG8_SB(0, 1), cB + hstep, voffB); PG8_STAGE(PG8_SA(0, 1), cA + hstep, voffA);
        if (wr == 1) PG8_BAR;
        PG8_WAIT_V(4); PG8_BAR;
        PG8_STAGE(PG8_SB(1, 0), cB + kstep, voffB); PG8_STAGE(PG8_SA(1, 0), cA + kstep, voffA); PG8_STAGE(PG8_SB(1, 1), cB + hstep + kstep, voffB);
        PG8_WAIT_V(6); PG8_BAR;
    }
    for (;;) {
        const bool has_next = S.next(ui + 1, nxt);
        const char* nA = has_next ? (const char*)g.A + (size_t)nxt.pm * tstep : cA; const char* nB = has_next ? (const char*)g.Bt + (size_t)nxt.pn * tstep : cB;
        for (int t = 0; t < nt; t += 2) {
            const bool last = (t == nt - 2);
            const char* a1 = cA + (size_t)(t + 1) * kstep;
            const char* a2 = last ? nA : cA + (size_t)(t + 2) * kstep; const char* b2 = last ? nB : cB + (size_t)(t + 2) * kstep;
            const char* a3 = a2 + kstep; const char* b3 = b2 + kstep;
            if (last && has_next) S.a_ready(nxt);
            if constexpr (SP2) {
            PG8_LDB(B0, 0, 0); PG8_LDB(B1, 0, 1); PG8_SCHED; PG8_LDA(At, 0, 0); PG8_STAGE(PG8_SA(1, 1), a1 + hstep, voffA);
            PG8_WAIT_V(8); PG8_WAIT_L(0); PG8_BAR; PG8_MMA(0, 0, At, B0); PG8_MMA(0, 1, At, B1); PG8_BAR; PG8_SCHED;
            PG8_LDA(At, 0, 1); PG8_STAGE(PG8_SB(0, 0), b2, voffB); PG8_STAGE(PG8_SB(0, 1), b2 + hstep, voffB); PG8_STAGE(PG8_SA(0, 0), a2, voffA);
            PG8_WAIT_V(8); PG8_WAIT_L(0); PG8_BAR; PG8_MMA(1, 0, At, B0); PG8_MMA(1, 1, At, B1); PG8_BAR; PG8_SCHED;
            PG8_LDB(B0, 1, 0); PG8_LDB(B1, 1, 1); PG8_SCHED; PG8_LDA(At, 1, 0); PG8_STAGE(PG8_SA(0, 1), a2 + hstep, voffA);
            PG8_WAIT_V(8); PG8_WAIT_L(0); PG8_BAR; PG8_MMA(0, 0, At, B0); PG8_MMA(0, 1, At, B1); PG8_BAR; PG8_SCHED;
            PG8_LDA(At, 1, 1); PG8_STAGE(PG8_SB(1, 0), b3, voffB); PG8_STAGE(PG8_SB(1, 1), b3 + hstep, voffB); PG8_STAGE(PG8_SA(1, 0), a3, voffA);
            PG8_WAIT_V(8); PG8_WAIT_L(0); PG8_BAR; PG8_MMA(1, 0, At, B0); PG8_MMA(1, 1, At, B1); PG8_BAR; PG8_SCHED;
            } else {
            PG8_LDB(B0, 0, 0); PG8_SCHED; PG8_LDA(At, 0, 0); PG8_STAGE(PG8_SA(1, 1), a1 + hstep, voffA);
            PG8_WAIT_L(8); PG8_BAR; PG8_WAIT_L(0); PG8_MMA(0, 0, At, B0); PG8_BAR; PG8_SCHED;
            PG8_LDB(B1, 0, 1); PG8_STAGE(PG8_SB(0, 0), b2, voffB);
            PG8_BAR; PG8_WAIT_L(0); PG8_MMA(0, 1, At, B1); PG8_BAR;
            PG8_LDA(At, 0, 1); PG8_STAGE(PG8_SA(0, 0), a2, voffA);
            PG8_BAR; PG8_WAIT_L(0); PG8_MMA(1, 0, At, B0); PG8_BAR; PG8_SCHED;
            PG8_STAGE(PG8_SB(0, 1), b2 + hstep, voffB);
            PG8_WAIT_V(6); PG8_BAR; PG8_MMA(1, 1, At, B1); PG8_BAR;
            PG8_LDB(B0, 1, 0); PG8_SCHED; PG8_LDA(At, 1, 0); PG8_STAGE(PG8_SA(0, 1), a2 + hstep, voffA);
            PG8_WAIT_L(8); PG8_BAR; PG8_WAIT_L(0); PG8_MMA(0, 0, At, B0); PG8_BAR; PG8_SCHED;
            PG8_LDB(B1, 1, 1); PG8_STAGE(PG8_SB(1, 0), b3, voffB);
            PG8_BAR; PG8_WAIT_L(0); PG8_MMA(0, 1, At, B1); PG8_BAR;
            PG8_LDA(At, 1, 1); PG8_STAGE(PG8_SA(1, 0), a3, voffA);
            PG8_BAR; PG8_WAIT_L(0); PG8_MMA(1, 0, At, B0); PG8_BAR; PG8_SCHED;
            PG8_STAGE(PG8_SB(1, 1), b3 + hstep, voffB);
            PG8_WAIT_V(6); PG8_BAR; PG8_MMA(1, 1, At, B1); PG8_BAR;
            }
        }
        if constexpr (ALIGN_EPI) { if (wr == 0) PG8_BAR; }
        if constexpr (!Epi::AFTER_DRAIN) { E(acc, cur, wr, wc, fr, fq); S.done(cur); }
        if (!has_next) break;
#pragma unroll
        for (int a = 0; a < 2; ++a)
#pragma unroll
            for (int b = 0; b < 2; ++b)
#pragma unroll
                for (int m = 0; m < 4; ++m)
#pragma unroll
                    for (int n = 0; n < 2; ++n) acc[a][b][m][n] = (f32x4){0.f, 0.f, 0.f, 0.f};
        cur = nxt; cA = nA; cB = nB; ++ui;
        if constexpr (ALIGN_EPI) { if (wr == 1) PG8_BAR; }
    }
    PG8_WAIT_V(0);
    if constexpr (!ALIGN_EPI) { if (wr == 0) PG8_BAR; }
    PG8_BAR;
    if constexpr (Epi::AFTER_DRAIN) { E.fused(acc, cur, wr, wc, fr, fq, lds, wid, lane); S.done(cur); }
#undef PG8_SA
#undef PG8_SB
#undef PG8_STAGE
#undef PG8_LDA
#undef PG8_LDB
#undef PG8_MMA
#undef PG8_WAIT_V
#undef PG8_WAIT_L
#undef PG8_BAR
#undef PG8_SCHED
}
}

namespace att {
#define ATT_LAS __attribute__((address_space(3)))
typedef unsigned short bf16_t;
typedef short bf16x8 __attribute__((ext_vector_type(8)));
typedef short s16x4 __attribute__((ext_vector_type(4)));
typedef float f32x16 __attribute__((ext_vector_type(16)));
typedef unsigned u32x4 __attribute__((ext_vector_type(4)));
typedef unsigned u32x2 __attribute__((ext_vector_type(2)));
constexpr float LOG2E = 1.4426950408889634f, LN2 = 0.6931471805599453f, CS = 0.125f * LOG2E;
constexpr int VROW = 192, VLDS_BYTES = 32 * VROW;
__device__ __forceinline__ unsigned pkbf(float lo, float hi) { unsigned r; asm volatile("v_cvt_pk_bf16_f32 %0, %1, %2" : "=v"(r) : "v"(lo), "v"(hi)); return r; }
__device__ __forceinline__ s16x4 vtr(const ATT_LAS unsigned char* p) { return __builtin_bit_cast(s16x4, __builtin_amdgcn_ds_read_tr16_b64_v4i16((ATT_LAS s16x4*)p)); }

template <class P>
__device__ __forceinline__ void attend(const P& pol, ATT_LAS unsigned char* vlds, int lane, f32x16& o0, f32x16& o1, float& m, float& l) {
    const int n = lane & 31, h = lane >> 5;
    bf16x8 qf[4];
    { const bf16_t* qrow = pol.q_row(n) + 32 * h;
#pragma unroll
      for (int ks = 0; ks < 4; ++ks) qf[ks] = *(const bf16x8*)(qrow + 8 * ks); }
#pragma unroll
    for (int i = 0; i < 16; ++i) { o0[i] = 0.f; o1[i] = 0.f; }
    m = pol.m_init(); l = pol.l_init(h);
    const int t_lo = pol.t_lo(), t_hi = pol.t_hi();
    bf16x8 kf[4]; u32x4 vp[4];
    { const bf16_t* krow = pol.key_row(t_lo, n) + 32 * h;
#pragma unroll
      for (int ks = 0; ks < 4; ++ks) kf[ks] = *(const bf16x8*)(krow + 8 * ks);
#pragma unroll
      for (int i = 0; i < 4; ++i) vp[i] = *(const u32x4*)(pol.key_row(t_lo, (lane >> 3) + 8 * i) + pol.voff() + 8 * (lane & 7)); }
    const int vwr = (lane >> 3) * VROW + (lane & 7) * 16;
    const int vrd = (4 * h + ((lane & 15) >> 2)) * VROW + (16 * ((lane >> 4) & 1) + 4 * (lane & 3)) * 2;
    for (int t = t_lo; t < t_hi; ++t) {
        bf16x8 kn[4]; u32x4 vn[4];
        const int tn = (t + 1 < t_hi) ? t + 1 : t;
        { const bf16_t* krow = pol.key_row(tn, n) + 32 * h;
#pragma unroll
          for (int ks = 0; ks < 4; ++ks) kn[ks] = *(const bf16x8*)(krow + 8 * ks);
#pragma unroll
          for (int i = 0; i < 4; ++i) vn[i] = *(const u32x4*)(pol.key_row(tn, (lane >> 3) + 8 * i) + pol.voff() + 8 * (lane & 7)); }
        f32x16 s;
#pragma unroll
        for (int i = 0; i < 16; ++i) s[i] = 0.f;
#pragma unroll
        for (int ks = 0; ks < 4; ++ks) s = __builtin_amdgcn_mfma_f32_32x32x16_bf16(kf[ks], qf[ks], s, 0, 0, 0);
        float mx = -INFINITY;
#pragma unroll
        for (int i = 0; i < 16; ++i) { s[i] = pol.score(t, (i & 3) + 8 * (i >> 2) + 4 * h, s[i]); mx = fmaxf(mx, s[i]); }
        mx = fmaxf(mx, __shfl_xor(mx, 32));
        const float mn = fmaxf(m, mx), al = __builtin_amdgcn_exp2f(m - mn); m = mn;
        float ps = 0.f;
#pragma unroll
        for (int i = 0; i < 16; ++i) { s[i] = __builtin_amdgcn_exp2f(s[i] - mn); ps += s[i]; }
        l = l * al + ps;
#pragma unroll
        for (int i = 0; i < 16; ++i) { o0[i] *= al; o1[i] *= al; }
        bf16x8 pf[2];
#pragma unroll
        for (int s2 = 0; s2 < 2; ++s2) { u32x4 w; w.x = pkbf(s[8 * s2 + 0], s[8 * s2 + 1]); w.y = pkbf(s[8 * s2 + 2], s[8 * s2 + 3]); w.z = pkbf(s[8 * s2 + 4], s[8 * s2 + 5]); w.w = pkbf(s[8 * s2 + 6], s[8 * s2 + 7]);
            pf[s2] = __builtin_bit_cast(bf16x8, w); }
#pragma unroll
        for (int i = 0; i < 4; ++i) *(ATT_LAS u32x4*)(vlds + vwr + i * 8 * VROW) = vp[i];
        asm volatile("s_waitcnt lgkmcnt(0)" ::: "memory");
#pragma unroll
        for (int s2 = 0; s2 < 2; ++s2) {
            const s16x4 a0 = vtr(vlds + vrd + s2 * 16 * VROW), b0 = vtr(vlds + vrd + s2 * 16 * VROW + 8 * VROW);
            const s16x4 a1 = vtr(vlds + vrd + s2 * 16 * VROW + 64), b1 = vtr(vlds + vrd + s2 * 16 * VROW + 8 * VROW + 64);
            const bf16x8 v0 = (bf16x8){a0[0], a0[1], a0[2], a0[3], b0[0], b0[1], b0[2], b0[3]}, v1 = (bf16x8){a1[0], a1[1], a1[2], a1[3], b1[0], b1[1], b1[2], b1[3]};
            o0 = __builtin_amdgcn_mfma_f32_32x32x16_bf16(v0, pf[s2], o0, 0, 0, 0);
            o1 = __builtin_amdgcn_mfma_f32_32x32x16_bf16(v1, pf[s2], o1, 0, 0, 0);
        }
        asm volatile("s_waitcnt lgkmcnt(0)" ::: "memory");
#pragma unroll
        for (int ks = 0; ks < 4; ++ks) kf[ks] = kn[ks];
#pragma unroll
        for (int i = 0; i < 4; ++i) vp[i] = vn[i];
    }
    l += __shfl_xor(l, 32);
}
__device__ __forceinline__ void store_o(bf16_t* orow, const f32x16& o0, const f32x16& o1, float inv, int h) {
#pragma unroll
    for (int a = 0; a < 4; ++a) { u32x2 w0, w1;
        w0.x = pkbf(o0[4 * a] * inv, o0[4 * a + 1] * inv); w0.y = pkbf(o0[4 * a + 2] * inv, o0[4 * a + 3] * inv);
        w1.x = pkbf(o1[4 * a] * inv, o1[4 * a + 1] * inv); w1.y = pkbf(o1[4 * a + 2] * inv, o1[4 * a + 3] * inv);
        *(u32x2*)(orow + 8 * a + 4 * h) = w0; *(u32x2*)(orow + 32 + 8 * a + 4 * h) = w1; }
}

constexpr int SEQ = 16384, MROWS = 2 * SEQ;
struct PolB {
    const bf16_t* QKV; size_t rowq; int p0, head, kvh; float sink;
    __device__ __forceinline__ const bf16_t* q_row(int n) const { return QKV + (rowq + n) * 1536 + head * 64; }
    __device__ __forceinline__ const bf16_t* key_row(int t, int r) const { return QKV + (size_t)((ptrdiff_t)rowq + (-128 + 32 * t + r)) * 1536 + 1024 + kvh * 64; }
    __device__ __forceinline__ int voff() const { return 256; }
    __device__ __forceinline__ int t_lo() const { return p0 < 128 ? (128 - p0) / 32 : 0; }
    __device__ __forceinline__ int t_hi() const { const int x = (SEQ + 128 - p0) / 32; return x < 9 ? x : 9; }
    int nq;
    __device__ __forceinline__ float score(int t, int kk, float raw) const { const bool ok = (t == 0) ? (kk >= nq) : ((t == 8) ? (kk <= nq) : true); return ok ? raw * CS : -INFINITY; }
    __device__ __forceinline__ float m_init() const { return sink * LOG2E; }
    __device__ __forceinline__ float l_init(int h) const { return h == 0 ? 1.f : 0.f; }
};
__device__ __forceinline__ void attn_B(const bf16_t* QKV, const float* sink, bf16_t* O, ATT_LAS unsigned char* vlds, int gw, int ngw, int lane) {
    for (int it = gw; it < 2 * 16 * 512; it += ngw) { const int blk = it & 511, head = (it >> 9) & 15, b = it >> 13;
        PolB p; p.QKV = QKV; p.p0 = 32 * blk; p.rowq = (size_t)b * SEQ + p.p0; p.head = head; p.kvh = head >> 2; p.sink = sink[head]; p.nq = lane & 31;
        f32x16 o0, o1; float m, l; attend(p, vlds, lane, o0, o1, m, l);
        store_o(O + (p.rowq + (lane & 31)) * 1024 + head * 64, o0, o1, 1.0f / l, lane >> 5); }
}
struct PolA {
    const bf16_t* QKV; size_t rowb; int i0, d, res, gh, sub, nq;
    __device__ __forceinline__ const bf16_t* q_row(int n) const { return QKV + (rowb + (size_t)(i0 + n) * d + res) * 4608 + gh * 64; }
    __device__ __forceinline__ const bf16_t* key_row(int t, int r) const { return QKV + (size_t)((ptrdiff_t)rowb + (ptrdiff_t)(i0 - 64 + 32 * t + r) * d + res) * 4608 + 1536 + gh * 64; }
    __device__ __forceinline__ int voff() const { return 1536; }
    __device__ __forceinline__ int t_lo() const { return i0 < 64 ? (64 - i0) / 32 : 0; }
    __device__ __forceinline__ int t_hi() const { const int x = (sub + 64 - i0) / 32; return x < 5 ? x : 5; }
    __device__ __forceinline__ float score(int t, int kk, float raw) const { const bool ok = (t == 0) ? (kk >= nq) : ((t == 4) ? (kk <= nq) : true); return ok ? raw * CS : -INFINITY; }
    __device__ __forceinline__ float m_init() const { return -1e30f; }
    __device__ __forceinline__ float l_init(int) const { return 0.f; }
};
__device__ __forceinline__ void attn_A(const bf16_t* QKV, bf16_t* OG0, bf16_t* OG1, bf16_t* OG2, float* LSE, ATT_LAS unsigned char* vlds, int gw, int ngw, int lane) {
    for (int it = gw; it < 2 * 24 * 512; it += ngw) { const int w = it & 511, gh = (it >> 9) % 24, b = it / (24 * 512), g = gh >> 3, hh = gh & 7;
        const int d = (g == 0) ? 1 : (g == 1 ? 4 : 16), sub = SEQ / d, nblk = sub / 32, res = w / nblk, blk = w % nblk;
        PolA p; p.QKV = QKV; p.rowb = (size_t)b * SEQ; p.i0 = 32 * blk; p.d = d; p.res = res; p.gh = gh; p.sub = sub; p.nq = lane & 31;
        f32x16 o0, o1; float m, l; attend(p, vlds, lane, o0, o1, m, l);
        const size_t row = p.rowb + (size_t)(p.i0 + (lane & 31)) * d + res;
        bf16_t* OG = (g == 0) ? OG0 : (g == 1 ? OG1 : OG2);
        store_o(OG + row * 512 + hh * 64, o0, o1, 1.0f / l, lane >> 5);
        if (lane < 32) LSE[((size_t)g * MROWS + row) * 8 + hh] = (m + __builtin_amdgcn_logf(l)) * LN2; }
}
struct PolC {
    const bf16_t* QKV; const float* rpb; size_t rowb; int r0, rs0, rs1, nblk, kstart, head; int qr, qc, rsq, cs;
    __device__ __forceinline__ const bf16_t* q_row(int n) const { return QKV + (rowb + (size_t)(r0 + (n >> 4)) * 64 + 16 * nblk + (n & 15)) * 3072 + head * 64; }
    __device__ __forceinline__ const bf16_t* key_row(int t, int r) const { return QKV + (rowb + (size_t)(rs0 + t) * 64 + kstart + r) * 3072 + 1024 + head * 64; }
    __device__ __forceinline__ int voff() const { return 1024; }
    __device__ __forceinline__ int t_lo() const { return 0; }
    __device__ __forceinline__ int t_hi() const { return rs1 + 8 - rs0; }
    __device__ __forceinline__ float score(int t, int kk, float raw) const { const int krow = rs0 + t, kc = kstart + kk;
        const bool ok = (krow >= rsq) && (krow < rsq + 8) && (kc >= cs) && (kc < cs + 16);
        const int idx = ok ? (krow - qr + 7) * 31 + (kc - qc + 15) : 0;
        const float bias = rpb[idx];
        return ok ? raw * CS + bias * LOG2E : -INFINITY; }
    __device__ __forceinline__ float m_init() const { return -1e30f; }
    __device__ __forceinline__ float l_init(int) const { return 0.f; }
};
__device__ __forceinline__ void attn_C(const bf16_t* QKV, const float* rpb, bf16_t* O, ATT_LAS unsigned char* vlds, int gw, int ngw, int lane) {
    for (int it = gw; it < 2 * 16 * 512; it += ngw) { const int nblk = it & 3, a = (it >> 2) & 127, head = (it >> 9) & 15, b = it >> 13, n = lane & 31;
        PolC p; p.QKV = QKV; p.rpb = rpb + head * 465; p.rowb = (size_t)b * SEQ; p.r0 = 2 * a; p.rs0 = min(max(p.r0 - 4, 0), 248); p.rs1 = min(max(p.r0 - 3, 0), 248); p.nblk = nblk;
        p.kstart = min(max(16 * nblk - 8, 0), 32); p.head = head; p.qr = p.r0 + (n >> 4); p.qc = 16 * nblk + (n & 15); p.rsq = (n >> 4) ? p.rs1 : p.rs0; p.cs = min(max(p.qc - 8, 0), 48);
        f32x16 o0, o1; float m, l; attend(p, vlds, lane, o0, o1, m, l);
        store_o(O + (p.rowb + (size_t)p.qr * 64 + p.qc) * 1024 + head * 64, o0, o1, 1.0f / l, lane >> 5); }
}
}

#define LAS __attribute__((address_space(3)))
typedef unsigned short bf16_t;
typedef float f32x4 __attribute__((ext_vector_type(4)));
typedef unsigned u32x4 __attribute__((ext_vector_type(4)));
typedef unsigned u32x2 __attribute__((ext_vector_type(2)));
constexpr int SEQ = 16384, NB = 2, M = NB * SEQ, D = 1024, DFF = 2816, DEPTH = 4, PLE = 256;
constexpr float EPS = 1e-6f;
constexpr int NWAVES = 8, NTHR = 512;
constexpr int LDS_BYTES = 147456;
constexpr int PH_PER_LAYER = 14, NPHASES = 1 + DEPTH * PH_PER_LAYER;

constexpr size_t MiB = 1u << 20;
constexpr size_t WS_CTL = 0, WS_ROPE = 1 * MiB, WS_LSE = 2 * MiB, WS_W = 8 * MiB, WS_PBF = 183 * MiB, WS_XN = 199 * MiB, WS_O = 263 * MiB, WS_BIG = 327 * MiB, WS_END = 615 * MiB;
constexpr size_t WS_Y = WS_BIG + 176 * MiB;
constexpr size_t WS_E = WS_BIG;
constexpr size_t W_WI = 0, W_WO = W_WI + (size_t)8 * D * 2 * DFF, W_PP = W_WO + (size_t)8 * DFF * D, W_PG = W_PP + (size_t)4 * PLE * D, W_AQ = W_PG + (size_t)4 * D * D,
                 W_AO = W_AQ + (size_t)2 * D * 4608, W_BQ = W_AO + (size_t)2 * 512 * D, W_BO = W_BQ + (size_t)D * 1536, W_CQ = W_BO + (size_t)D * D, W_CO = W_CQ + (size_t)D * 3072, W_END = W_CO + (size_t)D * D;
static_assert(WS_W + W_END * 2 <= WS_PBF, "weight region");

struct Args { const float* in[15]; float* out; unsigned char* ws; int ph_lo, ph_hi; };
constexpr int TAB_OFF = 131072 + 1024, T_OUT = 15, T_WS = 16;
__device__ __forceinline__ const float* tabp(LAS unsigned char* lds, int k) {
    const LAS unsigned* t = (const LAS unsigned*)(lds + TAB_OFF) + 2 * k;
    const unsigned lo = __builtin_amdgcn_readfirstlane(t[0]), hi = __builtin_amdgcn_readfirstlane(t[1]);
    return (const float*)(((unsigned long long)hi << 32) | lo);
}

__device__ __forceinline__ float bf_lo(unsigned u) { return __uint_as_float(u << 16); }
__device__ __forceinline__ float bf_hi(unsigned u) { return __uint_as_float(u & 0xffff0000u); }
__device__ __forceinline__ unsigned pk2(float lo, float hi) { return pg8::cvt_pk_bf16(lo, hi); }
__device__ __forceinline__ float wave_sum(float v) {
#pragma unroll
    for (int o = 1; o < 64; o <<= 1) v += __shfl_xor(v, o);
    return v;
}

constexpr float INV0 = 0x1.0000000000000p+0f, INV1 = 0x1.8d275e0000000p-3f, INV2 = 0x1.3411900000000p-5f, INV3 = 0x1.ddee9c0000000p-8f, INV4 = 0x1.72ba440000000p-10f, INV5 = 0x1.1f91f00000000p-12f, INV6 = 0x1.be21880000000p-15f, INV7 = 0x1.5a0f4e0000000p-17f;
__device__ __forceinline__ void transpose_item(const float* W, int K, int N, bf16_t* WT, int perm, LAS float* scr, int item, int lane) {
    const int nblk = N / 32, kb = item / nblk, nb = item % nblk, k0 = 64 * kb, n0 = 32 * nb;
    int ns = n0;
    if (perm) { const int pn = n0 >> 8, w = n0 & 255; ns = (w < 128) ? pn * 128 + w : DFF + pn * 128 + (w - 128); }
#pragma unroll 8
    for (int i = 0; i < 32; ++i) { const int kk = 2 * i + (lane >> 5); scr[kk * 33 + (lane & 31)] = W[(size_t)(k0 + kk) * N + ns + (lane & 31)]; }
    asm volatile("s_waitcnt lgkmcnt(0)" ::: "memory");
    const int c = lane & 7;
#pragma unroll
    for (int j = 0; j < 4; ++j) { const int n = (lane >> 3) + 8 * j; const LAS float* s = scr + (8 * c) * 33 + n;
        u32x4 o; o.x = pk2(s[0 * 33], s[1 * 33]); o.y = pk2(s[2 * 33], s[3 * 33]); o.z = pk2(s[4 * 33], s[5 * 33]); o.w = pk2(s[6 * 33], s[7 * 33]);
        *(u32x4*)(WT + (size_t)(n0 + n) * K + k0 + 8 * c) = o; }
    asm volatile("s_waitcnt lgkmcnt(0)" ::: "memory");
}
__device__ __forceinline__ void conv_matrix(const float* W, int K, int N, bf16_t* WT, int perm, LAS float* scr, int gw, int ngw, int lane) {
    const int nitems = (K / 64) * (N / 32);
    for (int it = gw; it < nitems; it += ngw) transpose_item(W, K, N, WT, perm, scr, it, lane);
}
__device__ __forceinline__ void first_norm_row(const float* xrow, float* hrow, bf16_t* xnrow, const float* g, int lane) {
    f32x4 v[4]; float s = 0.f;
#pragma unroll
    for (int j = 0; j < 4; ++j) { v[j] = ((const f32x4*)xrow)[lane + 64 * j]; s += (v[j].x * v[j].x + v[j].y * v[j].y) + (v[j].z * v[j].z + v[j].w * v[j].w); }
    const float rstd = 1.0f / sqrtf(wave_sum(s) * (1.0f / D) + EPS);
#pragma unroll
    for (int j = 0; j < 4; ++j) { ((f32x4*)hrow)[lane + 64 * j] = v[j]; const f32x4 gg = ((const f32x4*)g)[lane + 64 * j];
        u32x2 w; w.x = pk2(v[j].x * rstd * gg.x, v[j].y * rstd * gg.y); w.y = pk2(v[j].z * rstd * gg.z, v[j].w * rstd * gg.w);
        ((u32x2*)xnrow)[lane + 64 * j] = w; }
}
__device__ __forceinline__ void prologue(LAS unsigned char* lds, int G, int bx) {
    unsigned char* const ws = (unsigned char*)tabp(lds, T_WS);
    int tid_ = threadIdx.x; asm volatile("" : "+v"(tid_));
    const int tid = tid_, lane = tid & 63, wave = tid >> 6;
    const int gw = bx * NWAVES + wave, ngw = G * NWAVES;
    LAS float* scr = (LAS float*)(lds + wave * 16384);
    bf16_t* Wb = (bf16_t*)(ws + WS_W);
    for (int i = 0; i < 8; ++i) conv_matrix(tabp(lds, 3) + (size_t)i * D * 2 * DFF, D, 2 * DFF, Wb + W_WI + (size_t)i * D * 2 * DFF, 1, scr, gw, ngw, lane);
    for (int i = 0; i < 8; ++i) conv_matrix(tabp(lds, 4) + (size_t)i * DFF * D, DFF, D, Wb + W_WO + (size_t)i * DFF * D, 0, scr, gw, ngw, lane);
    for (int i = 0; i < 4; ++i) conv_matrix(tabp(lds, 5) + (size_t)i * PLE * D, PLE, D, Wb + W_PP + (size_t)i * PLE * D, 0, scr, gw, ngw, lane);
    for (int i = 0; i < 4; ++i) conv_matrix(tabp(lds, 6) + (size_t)i * D * D, D, D, Wb + W_PG + (size_t)i * D * D, 0, scr, gw, ngw, lane);
    for (int i = 0; i < 2; ++i) conv_matrix(tabp(lds, 7) + (size_t)i * D * 4608, D, 4608, Wb + W_AQ + (size_t)i * D * 4608, 0, scr, gw, ngw, lane);
    for (int i = 0; i < 2; ++i) conv_matrix(tabp(lds, 8) + (size_t)i * 512 * D, 512, D, Wb + W_AO + (size_t)i * 512 * D, 0, scr, gw, ngw, lane);
    conv_matrix(tabp(lds, 9), D, 1536, Wb + W_BQ, 0, scr, gw, ngw, lane);
    conv_matrix(tabp(lds, 10), D, D, Wb + W_BO, 0, scr, gw, ngw, lane);
    conv_matrix(tabp(lds, 12), D, 3072, Wb + W_CQ, 0, scr, gw, ngw, lane);
    conv_matrix(tabp(lds, 13), D, D, Wb + W_CO, 0, scr, gw, ngw, lane);
    float* rc = (float*)(ws + WS_ROPE); float* rs = rc + SEQ * 8;
    for (int i = bx * NTHR + tid; i < SEQ * 8; i += G * NTHR) { const int pos = i >> 3, f = i & 7;
        const float inv = f == 0 ? INV0 : f == 1 ? INV1 : f == 2 ? INV2 : f == 3 ? INV3 : f == 4 ? INV4 : f == 5 ? INV5 : f == 6 ? INV6 : INV7;
        const float ang = (float)pos * inv; double t = (double)ang * 0.15915494309189535; t -= rint(t);
        rc[i] = __builtin_amdgcn_cosf((float)t); rs[i] = __builtin_amdgcn_sinf((float)t); }
    bf16_t* XN = (bf16_t*)(ws + WS_XN);
    const float* xin = tabp(lds, 0); float* hout = (float*)tabp(lds, T_OUT); const float* g00 = tabp(lds, 2);
    for (int m = gw; m < M; m += ngw) first_norm_row(xin + (size_t)m * D, hout + (size_t)m * D, XN + (size_t)m * D, g00, lane);
}

__device__ __forceinline__ void norm_rows(const bf16_t* Y, const bf16_t* E, float c, const float* g1, const float* g2, float* H, bf16_t* XN, int gw, int ngw, int lane) {
    for (int m = gw; m < M; m += ngw) {
        f32x4 y[4]; float s = 0.f;
#pragma unroll
        for (int j = 0; j < 4; ++j) { const u32x2 w = ((const u32x2*)(Y + (size_t)m * D))[lane + 64 * j]; y[j] = (f32x4){bf_lo(w.x), bf_hi(w.x), bf_lo(w.y), bf_hi(w.y)};
            if (E) { const u32x2 e = ((const u32x2*)(E + (size_t)m * D))[lane + 64 * j]; const f32x4 ev = (f32x4){bf_lo(e.x), bf_hi(e.x), bf_lo(e.y), bf_hi(e.y)};
#pragma unroll
                for (int k = 0; k < 4; ++k) y[j][k] = ev[k] / (1.0f + __expf(-y[j][k])); }
            s += (y[j].x * y[j].x + y[j].y * y[j].y) + (y[j].z * y[j].z + y[j].w * y[j].w); }
        const float rstd = 1.0f / sqrtf(wave_sum(s) * (1.0f / D) + EPS);
        f32x4 h[4]; float s2 = 0.f;
#pragma unroll
        for (int j = 0; j < 4; ++j) { const f32x4 hv = ((const f32x4*)(H + (size_t)m * D))[lane + 64 * j]; const f32x4 gg = ((const f32x4*)g1)[lane + 64 * j];
            h[j] = hv + c * (y[j] * rstd) * gg; s2 += (h[j].x * h[j].x + h[j].y * h[j].y) + (h[j].z * h[j].z + h[j].w * h[j].w); }
        const float rstd2 = 1.0f / sqrtf(wave_sum(s2) * (1.0f / D) + EPS);
#pragma unroll
        for (int j = 0; j < 4; ++j) { ((f32x4*)(H + (size_t)m * D))[lane + 64 * j] = h[j]; const f32x4 gg = ((const f32x4*)g2)[lane + 64 * j];
            u32x2 w; w.x = pk2(h[j].x * rstd2 * gg.x, h[j].y * rstd2 * gg.y); w.y = pk2(h[j].z * rstd2 * gg.z, h[j].w * rstd2 * gg.w);
            ((u32x2*)(XN + (size_t)m * D))[lane + 64 * j] = w; }
    }
}
__device__ __forceinline__ void conv_p(const float* P, bf16_t* PB, int gt, int ngt) {
    for (int i = gt; i < M * PLE / 8; i += ngt) { const f32x4 a = ((const f32x4*)P)[2 * i], b = ((const f32x4*)P)[2 * i + 1];
        u32x4 w; w.x = pk2(a.x, a.y); w.y = pk2(a.z, a.w); w.z = pk2(b.x, b.y); w.w = pk2(b.z, b.w); ((u32x4*)PB)[i] = w; }
}

__device__ __forceinline__ void rope_pass(bf16_t* QKV, int ld, int nrh, const float* rc, const float* rs, int gt, int ngt) {
    for (int it = gt; it < M * nrh; it += ngt) { const int row = it / nrh, hh = it % nrh, pos = row % SEQ;
        u32x4* p = (u32x4*)(QKV + (size_t)row * ld + hh * 64); const u32x4 w1 = p[0], w2 = p[1];
        const f32x4 c0 = ((const f32x4*)(rc + pos * 8))[0], c1 = ((const f32x4*)(rc + pos * 8))[1], s0 = ((const f32x4*)(rs + pos * 8))[0], s1 = ((const f32x4*)(rs + pos * 8))[1];
        float x1[8], x2[8], cc[8], ss[8], o1[8], o2[8];
#pragma unroll
        for (int k = 0; k < 4; ++k) { x1[2 * k] = bf_lo(w1[k]); x1[2 * k + 1] = bf_hi(w1[k]); x2[2 * k] = bf_lo(w2[k]); x2[2 * k + 1] = bf_hi(w2[k]); cc[k] = c0[k]; cc[4 + k] = c1[k]; ss[k] = s0[k]; ss[4 + k] = s1[k]; }
#pragma unroll
        for (int k = 0; k < 8; ++k) { o1[k] = x1[k] * cc[k] - x2[k] * ss[k]; o2[k] = x2[k] * cc[k] + x1[k] * ss[k]; }
        u32x4 r1, r2;
#pragma unroll
        for (int k = 0; k < 4; ++k) { r1[k] = pk2(o1[2 * k], o1[2 * k + 1]); r2[k] = pk2(o2[2 * k], o2[2 * k + 1]); }
        p[0] = r1; p[1] = r2; }
}

template <class KF>
__device__ __forceinline__ void naive_core(const bf16_t* qp, float m0, float l0, int nk, KF kf, float (&o)[64], float& m, float& l) {
    u32x4 q[8];
#pragma unroll
    for (int c = 0; c < 8; ++c) q[c] = ((const u32x4*)qp)[c];
    m = m0; l = l0;
#pragma unroll
    for (int d = 0; d < 64; ++d) o[d] = 0.f;
    for (int j = 0; j < nk; ++j) {
        const bf16_t* kp; const bf16_t* vp; float bias;
        if (!kf(j, kp, vp, bias)) continue;
        float s = 0.f;
#pragma unroll
        for (int c = 0; c < 8; ++c) { const u32x4 w = ((const u32x4*)kp)[c];
#pragma unroll
            for (int k = 0; k < 4; ++k) { s += bf_lo(q[c][k]) * bf_lo(w[k]); s += bf_hi(q[c][k]) * bf_hi(w[k]); } }
        s = s * 0.125f + bias;
        const float mn = fmaxf(m, s), al = __expf(m - mn), p = __expf(s - mn);
        l = l * al + p; m = mn;
#pragma unroll
        for (int c = 0; c < 8; ++c) { const u32x4 w = ((const u32x4*)vp)[c];
#pragma unroll
            for (int k = 0; k < 4; ++k) { o[8 * c + 2 * k] = o[8 * c + 2 * k] * al + p * bf_lo(w[k]); o[8 * c + 2 * k + 1] = o[8 * c + 2 * k + 1] * al + p * bf_hi(w[k]); } }
    }
}
__device__ __forceinline__ void store_o64(bf16_t* op, const float (&o)[64], float inv) {
#pragma unroll
    for (int c = 0; c < 8; ++c) { u32x4 w;
#pragma unroll
        for (int k = 0; k < 4; ++k) w[k] = pk2(o[8 * c + 2 * k] * inv, o[8 * c + 2 * k + 1] * inv);
        ((u32x4*)op)[c] = w; }
}
__device__ __forceinline__ void attn_naive_A(const bf16_t* QKV, bf16_t* OG0, bf16_t* OG1, bf16_t* OG2, float* LSE, int gt, int ngt) {
    for (int it = gt; it < M * 24; it += ngt) { const int gh = it / M, row = it % M, g = gh >> 3, h = gh & 7, pos = row % SEQ, dil = (g == 0) ? 1 : (g == 1 ? 4 : 16);
        const bf16_t* base = QKV + (size_t)row * 4608 + gh * 64;
        float o[64], m, l;
        naive_core(base, -1e30f, 0.f, 129, [&](int j, const bf16_t*& kp, const bf16_t*& vp, float& bias) -> bool {
            const int kpos = pos + (j - 64) * dil; if (kpos < 0 || kpos >= SEQ) return false;
            const bf16_t* kb = base + (ptrdiff_t)((j - 64) * dil) * 4608; kp = kb + 1536; vp = kb + 3072; bias = 0.f; return true; }, o, m, l);
        bf16_t* OG = (g == 0) ? OG0 : (g == 1 ? OG1 : OG2);
        store_o64(OG + (size_t)row * 512 + h * 64, o, 1.0f / l);
        LSE[((size_t)g * M + row) * 8 + h] = m + __logf(l); }
}
__device__ __forceinline__ void merge_A(const bf16_t* OG0, const bf16_t* OG1, const bf16_t* OG2, const float* LSE, bf16_t* O, int gt, int ngt) {
    for (int it = gt; it < M * 64; it += ngt) { const int row = it >> 6, h = (it >> 3) & 7, c = it & 7;
        const float l0 = LSE[((size_t)0 * M + row) * 8 + h], l1 = LSE[((size_t)1 * M + row) * 8 + h], l2 = LSE[((size_t)2 * M + row) * 8 + h];
        const float mx = fmaxf(l0, fmaxf(l1, l2)); float e0 = __expf(l0 - mx), e1 = __expf(l1 - mx), e2 = __expf(l2 - mx); const float inv = 1.0f / (e0 + e1 + e2); e0 *= inv; e1 *= inv; e2 *= inv;
        const size_t off = (size_t)row * 512 + h * 64 + c * 8;
        const u32x4 a = *(const u32x4*)(OG0 + off), b = *(const u32x4*)(OG1 + off), d = *(const u32x4*)(OG2 + off); u32x4 w;
#pragma unroll
        for (int k = 0; k < 4; ++k) w[k] = pk2(e0 * bf_lo(a[k]) + e1 * bf_lo(b[k]) + e2 * bf_lo(d[k]), e0 * bf_hi(a[k]) + e1 * bf_hi(b[k]) + e2 * bf_hi(d[k]));
        *(u32x4*)(O + off) = w; }
}
__device__ __forceinline__ void attn_naive_B(const bf16_t* QKV, const float* sink, bf16_t* O, int gt, int ngt) {
    for (int it = gt; it < M * 16; it += ngt) { const int h = it / M, row = it % M, pos = row % SEQ, kvh = h >> 2;
        const bf16_t* qp = QKV + (size_t)row * 1536 + h * 64;
        const bf16_t* kb0 = QKV + (size_t)row * 1536 + 1024 + kvh * 64;
        float o[64], m, l;
        naive_core(qp, sink[h], 1.0f, 257, [&](int j, const bf16_t*& kp, const bf16_t*& vp, float& bias) -> bool {
            const int kpos = pos + j - 128; if (kpos < 0 || kpos >= SEQ) return false;
            kp = kb0 + (ptrdiff_t)(j - 128) * 1536; vp = kp + 256; bias = 0.f; return true; }, o, m, l);
        store_o64(O + (size_t)row * 1024 + h * 64, o, 1.0f / l); }
}
__device__ __forceinline__ void attn_naive_C(const bf16_t* QKV, const float* rpb, bf16_t* O, int gt, int ngt) {
    for (int it = gt; it < M * 16; it += ngt) { const int h = it / M, row = it % M, b = row / SEQ, pos = row % SEQ, r = pos >> 6, c = pos & 63;
        const int rs = min(max(r - 4, 0), 248), cs = min(max(c - 8, 0), 48);
        const bf16_t* qp = QKV + (size_t)row * 3072 + h * 64;
        float o[64], m, l;
        naive_core(qp, -1e30f, 0.f, 128, [&](int j, const bf16_t*& kp, const bf16_t*& vp, float& bias) -> bool {
            const int kr = rs + (j >> 4), kc = cs + (j & 15); const size_t krow = (size_t)b * SEQ + kr * 64 + kc;
            kp = QKV + krow * 3072 + 1024 + h * 64; vp = kp + 1024; bias = rpb[h * 465 + (kr - r + 7) * 31 + (kc - c + 15)]; return true; }, o, m, l);
        store_o64(O + (size_t)row * 1024 + h * 64, o, 1.0f / l); }
}

#ifndef ATT_MFMA_A
#define ATT_MFMA_A 1
#endif
#ifndef ATT_MFMA_B
#define ATT_MFMA_B 1
#endif
#ifndef ATT_MFMA_C
#define ATT_MFMA_C 1
#endif
__device__ __forceinline__ void run_phase(LAS unsigned char* lds, int ph) {
    int tid_ = threadIdx.x; asm volatile("" : "+v"(tid_));
    int G_ = gridDim.x, bx_ = blockIdx.x; asm volatile("" : "+s"(G_), "+s"(bx_));
    const int tid = tid_, lane = tid & 63, wave = tid >> 6, G = G_, bx = bx_;
    const int gw = bx * NWAVES + wave, ngw = G * NWAVES, gt = bx * NTHR + tid, ngt = G * NTHR;
    if (ph == 0) { prologue(lds, G, bx); return; }
    const int L = (ph - 1) / PH_PER_LAYER, s = (ph - 1) % PH_PER_LAYER, mt = L % 3, mj = L / 3;
    unsigned char* ws = (unsigned char*)tabp(lds, T_WS);
    bf16_t* Wb = (bf16_t*)(ws + WS_W); bf16_t* XN = (bf16_t*)(ws + WS_XN); bf16_t* Ob = (bf16_t*)(ws + WS_O); bf16_t* BIG = (bf16_t*)(ws + WS_BIG);
    bf16_t* Yb = (bf16_t*)(ws + WS_Y); bf16_t* Eb = (bf16_t*)(ws + WS_E); bf16_t* PB = (bf16_t*)(ws + WS_PBF);
    float* LSE = (float*)(ws + WS_LSE); const float* rc = (const float*)(ws + WS_ROPE); const float* rs = rc + SEQ * 8;
    const float* gL = tabp(lds, 2) + (size_t)L * 8 * D; float* Hout = (float*)tabp(lds, T_OUT);
    const int nqkv = (mt == 0) ? 4608 : (mt == 1 ? 1536 : 3072);
    bf16_t* OG0 = XN; bf16_t* OG1 = XN + (size_t)M * 512; bf16_t* OG2 = Ob + (size_t)M * 512;
#define GEMM_STORE(KC_, A_, W_, N_, O_, LDC_) do { pg8::Gemm g{A_, W_, M, N_, KC_}; pg8::StaticOrder S; S.init(M, N_, G, bx); pg8::EpiStore E{O_, LDC_}; \
        pg8::gemm_phase<pg8::EpiStore, pg8::StaticOrder, false, true, KC_>(lds, g, S, E); } while (0)
    if (s == 0 || s == 9) {
        pg8::Gemm g{XN, Wb + W_WI + (size_t)(L * 2 + (s == 9)) * D * 2 * DFF, M, 2 * DFF, D}; pg8::StaticOrder S; S.init(M, 2 * DFF, G, bx);
        pg8::EpiSwiGLU E{BIG, DFF};
        pg8::gemm_phase<pg8::EpiSwiGLU, pg8::StaticOrder, false, true, D>(lds, g, S, E);
        return;
    }
    if (s == 1 || s == 10) { GEMM_STORE(DFF, BIG, Wb + W_WO + (size_t)(L * 2 + (s == 10)) * DFF * D, D, Yb, D); return; }
    if (s == 3 || s == 7 || s == 12) {
        if (s == 7 && mt == 0) { GEMM_STORE(512, Ob, Wb + W_AO + (size_t)mj * 512 * D, D, Yb, D); return; }
        if (s == 12) { GEMM_STORE(PLE, PB, Wb + W_PP + (size_t)L * PLE * D, D, Eb, D); __syncthreads(); }
        const bf16_t* A_; const bf16_t* W_; bf16_t* O_; int N_;
        if (s == 3) { A_ = XN; W_ = (mt == 0) ? Wb + W_AQ + (size_t)mj * D * 4608 : (mt == 1 ? Wb + W_BQ : Wb + W_CQ); N_ = nqkv; O_ = BIG; }
        else if (s == 7) { A_ = Ob; W_ = (mt == 1) ? Wb + W_BO : Wb + W_CO; N_ = D; O_ = Yb; }
        else { A_ = XN; W_ = Wb + W_PG + (size_t)L * D * D; N_ = D; O_ = Yb; }
        GEMM_STORE(D, A_, W_, N_, O_, N_);
        return;
    }
    if (s == 2) { norm_rows(Yb, nullptr, 0.5f, gL + 1 * D, gL + 2 * D, Hout, XN, gw, ngw, lane); return; }
    if (s == 8) { norm_rows(Yb, nullptr, 1.0f, gL + 3 * D, gL + 4 * D, Hout, XN, gw, ngw, lane); conv_p(tabp(lds, 1) + (size_t)L * M * PLE, PB, gt, ngt); return; }
    if (s == 11) { norm_rows(Yb, nullptr, 0.5f, gL + 5 * D, gL + 6 * D, Hout, XN, gw, ngw, lane); return; }
    if (s == 13) { const float* gn = tabp(lds, 2) + (size_t)((L + 1) % DEPTH) * 8 * D; norm_rows(Yb, Eb, 1.0f, gL + 7 * D, gn, Hout, XN, gw, ngw, lane); return; }
    if (s == 4) { if (mt == 0) rope_pass(BIG, 4608, 48, rc, rs, gt, ngt); else if (mt == 1) rope_pass(BIG, 1536, 20, rc, rs, gt, ngt); return; }
    if (s == 5) {
        LAS unsigned char* vlds = lds + __builtin_amdgcn_readfirstlane(wave) * att::VLDS_BYTES;
        if (mt == 0) { if (ATT_MFMA_A) att::attn_A(BIG, OG0, OG1, OG2, LSE, vlds, gw, ngw, lane); else attn_naive_A(BIG, OG0, OG1, OG2, LSE, gt, ngt); }
        else if (mt == 1) { if (ATT_MFMA_B) att::attn_B(BIG, tabp(lds, 11), Ob, vlds, gw, ngw, lane); else attn_naive_B(BIG, tabp(lds, 11), Ob, gt, ngt); }
        else { if (ATT_MFMA_C) att::attn_C(BIG, tabp(lds, 14), Ob, vlds, gw, ngw, lane); else attn_naive_C(BIG, tabp(lds, 14), Ob, gt, ngt); }
        return;
    }
    if (s == 6) { if (mt == 0) merge_A(OG0, OG1, OG2, LSE, Ob, gt, ngt); return; }
}

__global__ void __launch_bounds__(NTHR) mk_fwd(Args a) {
    extern __shared__ __attribute__((aligned(16))) unsigned char lds_raw[];
    LAS unsigned char* lds = (LAS unsigned char*)lds_raw;
    cg::grid_group grid = cg::this_grid();
    if (threadIdx.x == 0) { LAS unsigned long long* t = (LAS unsigned long long*)(lds + TAB_OFF);
#pragma unroll
        for (int k = 0; k < 15; ++k) t[k] = (unsigned long long)a.in[k];
        t[T_OUT] = (unsigned long long)a.out; t[T_WS] = (unsigned long long)a.ws; }
    __syncthreads();
    const int lo = a.ph_lo, hi = a.ph_hi;
    for (int ph = lo; ph < hi; ++ph) {
        run_phase(lds, ph);
        if (ph + 1 < hi) grid.sync();
    }
}

#ifndef MK_ONE_LAUNCH
#define MK_ONE_LAUNCH 1
#endif
extern "C" void kernel_launch(void* const* d_in, const int* in_sizes, int n_in, void* d_out, int out_size, void* d_ws, size_t ws_size, hipStream_t stream) {
    static int grid = 0;
    if (grid == 0) {
        if (n_in != 15 || out_size != M * D || ws_size < WS_END) { fprintf(stderr, "kernel_launch: unexpected shapes: n_in %d out %d ws %zu (need %zu)\n", n_in, out_size, ws_size, (size_t)WS_END); grid = -1; return; }
        int dev = 0, cus = 0, per_cu = 0;
        hipGetDevice(&dev); hipDeviceGetAttribute(&cus, hipDeviceAttributeMultiprocessorCount, dev);
        if (hipFuncSetAttribute((const void*)mk_fwd, hipFuncAttributeMaxDynamicSharedMemorySize, LDS_BYTES) != hipSuccess) { fprintf(stderr, "kernel_launch: hipFuncSetAttribute failed\n"); grid = -1; return; }
        hipOccupancyMaxActiveBlocksPerMultiprocessor(&per_cu, (const void*)mk_fwd, NTHR, LDS_BYTES);
        (void)hipGetLastError();
        if (per_cu < 1) { fprintf(stderr, "kernel_launch: occupancy query says %d blocks/CU\n", per_cu); per_cu = 1; }
        grid = cus;
    }
    if (grid < 0) return;
    Args a{};
    for (int i = 0; i < 15; ++i) a.in[i] = (const float*)d_in[i];
    a.out = (float*)d_out; a.ws = (unsigned char*)d_ws;
#if MK_ONE_LAUNCH
    a.ph_lo = 0; a.ph_hi = NPHASES;
    void* args[] = {&a};
    hipError_t e = hipLaunchCooperativeKernel((const void*)mk_fwd, dim3(grid), dim3(NTHR), args, LDS_BYTES, stream);
    if (e != hipSuccess) fprintf(stderr, "cooperative launch failed: %s (grid %d)\n", hipGetErrorString(e), grid);
#else
    for (int ph = 0; ph < NPHASES; ++ph) {
        a.ph_lo = ph; a.ph_hi = ph + 1;
        hipLaunchKernelGGL(mk_fwd, dim3(grid), dim3(NTHR), LDS_BYTES, stream, a);
    }
#endif
}
```
